# Optimizing an MI355X kernel written in HIP

```python
import math
import jax, jax.numpy as jnp
from jax import lax
import numpy as np

D_MODEL = 2048
BATCH = 4
SEQ = 4096
DEPTH = 1

CHUNK = 64
LEFT_CHUNKS = 8
BAND = (LEFT_CHUNKS + 1) * CHUNK
MEM_LEN = 256
A_HEADS = 16
A_HEAD_DIM = 64
A_WIDTH = A_HEADS * A_HEAD_DIM
MAX_REL = 128
B_HEADS = 16
QK_NOPE = 128
QK_ROPE = 64
V_HEAD = 128
Q_LORA = 512
KV_LORA = 512
ROPE_THETA = 10000.0
B_WIDTH = B_HEADS * V_HEAD
Q_BLOCK = 128
X_HEADS = 4
X_HEAD_DIM = D_MODEL // X_HEADS
D_FF = 5504
N_BRANCH = 2
IN_SPLITS = (A_WIDTH, 2 * A_WIDTH, 3 * A_WIDTH, 3 * A_WIDTH + Q_LORA,
             3 * A_WIDTH + Q_LORA + KV_LORA + QK_ROPE)
IN_COLS = 3 * A_WIDTH + Q_LORA + KV_LORA + QK_ROPE + N_BRANCH * D_MODEL
ALPHA = (2.0 * DEPTH) ** 0.25
BETA = (8.0 * DEPTH) ** -0.25
LN_EPS = 1e-5
RMS_EPS = 1e-6
NEG_INF = -1e30

kernel_name = 'hybrid_chunked_mla_macaron_deepnorm'


def layer_norm(x, g, b):
    xf = x.astype(jnp.float32)
    mu = xf.mean(-1, keepdims=True)
    var = jnp.square(xf - mu).mean(-1, keepdims=True)
    y = (xf - mu) * lax.rsqrt(var + LN_EPS) * g.astype(jnp.float32) + b.astype(jnp.float32)
    return y.astype(x.dtype)


def rms_norm(x, g):
    xf = x.astype(jnp.float32)
    y = xf * lax.rsqrt(jnp.square(xf).mean(-1, keepdims=True) + RMS_EPS) * g.astype(jnp.float32)
    return y.astype(x.dtype)


def swiglu_ffn(x, w_in, w_out):
    g, u = jnp.split(x @ w_in, 2, axis=-1)
    return (jax.nn.silu(g) * u) @ w_out


def rope_tables(seq_len, dim):
    inv = 1.0 / (ROPE_THETA ** (jnp.arange(0, dim, 2, dtype=jnp.float32) / dim))
    ang = jnp.arange(seq_len, dtype=jnp.float32)[:, None] * inv[None, :]
    return jnp.cos(ang)[:, None, :], jnp.sin(ang)[:, None, :]


def apply_rope(x, cos, sin):
    x1, x2 = jnp.split(x.astype(jnp.float32), 2, axis=-1)
    return jnp.concatenate([x1 * cos - x2 * sin, x2 * cos + x1 * sin], axis=-1).astype(x.dtype)


def chunked_relbias_attention(q, k, v, rel_bias):
    b, s, h, d = q.shape
    nc = s // CHUNK
    qc = q.reshape(b, nc, CHUNK, h, d)

    def band(t):
        tc = t.reshape(b, nc, CHUNK, h, d)
        tp = jnp.pad(tc, ((0, 0), (LEFT_CHUNKS, 0), (0, 0), (0, 0), (0, 0)))
        return jnp.concatenate([tp[:, j:j + nc] for j in range(LEFT_CHUNKS + 1)], axis=2)

    kb, vb = band(k), band(v)
    scores = jnp.einsum('bcqhd,bckhd->bchqk', qc, kb).astype(jnp.float32) / math.sqrt(d)
    qi = jnp.arange(CHUNK)[:, None]
    kj = jnp.arange(BAND)[None, :]
    dist = LEFT_CHUNKS * CHUNK + qi - kj
    idx = jnp.clip(dist, -MAX_REL, MAX_REL) + MAX_REL
    bias = rel_bias.astype(jnp.float32)[:, idx]
    key_chunk = jnp.arange(nc)[:, None] - LEFT_CHUNKS + kj // CHUNK
    valid = key_chunk >= 0
    scores = jnp.where(valid[None, :, None, None, :], scores + bias[None, None], NEG_INF)
    p = jax.nn.softmax(scores, axis=-1).astype(v.dtype)
    o = jnp.einsum('bchqk,bckhd->bcqhd', p, vb)
    return o.reshape(b, s, h * d)


def mla_attention(q_lat, kv_lat, q_a_norm, w_q_b, kv_a_norm, w_kv_b, cos, sin):
    b, s, _ = q_lat.shape
    c_q = rms_norm(q_lat, q_a_norm)
    q = (c_q @ w_q_b).reshape(b, s, B_HEADS, QK_NOPE + QK_ROPE)
    q_nope, q_pe = jnp.split(q, [QK_NOPE], axis=-1)
    q = jnp.concatenate([q_nope, apply_rope(q_pe, cos, sin)], axis=-1)
    c_kv, k_pe = jnp.split(kv_lat, [KV_LORA], axis=-1)
    c_kv = rms_norm(c_kv, kv_a_norm)
    kv = (c_kv @ w_kv_b).reshape(b, s, B_HEADS, QK_NOPE + V_HEAD)
    k_nope, v = jnp.split(kv, [QK_NOPE], axis=-1)
    k_pe = apply_rope(k_pe[:, :, None, :], cos, sin)
    k = jnp.concatenate([k_nope, jnp.broadcast_to(k_pe, (b, s, B_HEADS, QK_ROPE))], axis=-1)
    scale = (QK_NOPE + QK_ROPE) ** -0.5
    nb = s // Q_BLOCK
    q_blocks = jnp.moveaxis(q.reshape(b, nb, Q_BLOCK, B_HEADS, QK_NOPE + QK_ROPE), 1, 0)
    key_chunk = jnp.arange(s) // CHUNK

    def block(args):
        qb, start = args
        sc = jnp.einsum('bqhd,bkhd->bhqk', qb, k).astype(jnp.float32) * scale
        q_chunk = (start + jnp.arange(Q_BLOCK)) // CHUNK
        allowed = key_chunk[None, :] <= q_chunk[:, None]
        sc = jnp.where(allowed[None, None], sc, NEG_INF)
        p = jax.nn.softmax(sc, axis=-1).astype(v.dtype)
        return jnp.einsum('bhqk,bkhd->bqhd', p, v)

    starts = jnp.arange(nb, dtype=jnp.int32) * Q_BLOCK
    o = lax.map(block, (q_blocks, starts))
    return jnp.moveaxis(o, 0, 1).reshape(b, s, B_WIDTH)


def hybrid_mixer(u, w_in, gate_bias, rel_bias, q_a_norm, w_q_b, kv_a_norm, w_kv_b,
                 w_o_a, w_o_b, w_out, cos, sin):
    b, s, _ = u.shape
    proj = u @ w_in
    qa, ka, va, q_lat, kv_lat, gates = jnp.split(proj, list(IN_SPLITS), axis=-1)
    shp = (b, s, A_HEADS, A_HEAD_DIM)
    y_a = chunked_relbias_attention(qa.reshape(shp), ka.reshape(shp), va.reshape(shp), rel_bias) @ w_o_a
    y_b = mla_attention(q_lat, kv_lat, q_a_norm, w_q_b, kv_a_norm, w_kv_b, cos, sin) @ w_o_b
    g = jax.nn.sigmoid((gates + gate_bias).astype(jnp.float32)).astype(u.dtype)
    g_a, g_b = jnp.split(g, 2, axis=-1)
    return (g_a * y_a + g_b * y_b) @ w_out


def memory_cross_attention(h, mem, mem_ln_g, mem_ln_b, w_xq, w_xkv, w_xo):
    b, s, _ = h.shape
    m_len = mem.shape[1]
    m = layer_norm(mem, mem_ln_g, mem_ln_b)
    q = (h @ w_xq).reshape(b, s, X_HEADS, X_HEAD_DIM)
    kv = (m @ w_xkv).reshape(b, m_len, 2, X_HEADS, X_HEAD_DIM)
    k, v = kv[:, :, 0], kv[:, :, 1]
    sc = jnp.einsum('bqhd,bkhd->bhqk', q, k).astype(jnp.float32) / math.sqrt(X_HEAD_DIM)
    p = jax.nn.softmax(sc, axis=-1).astype(v.dtype)
    o = jnp.einsum('bhqk,bkhd->bqhd', p, v).reshape(b, s, D_MODEL)
    return o @ w_xo


def setup_inputs(seed: int = 0) -> dict:
    key = jax.random.key(seed)
    ks = iter(jax.random.split(key, 40))

    def nrm(shape, scale):
        return jax.random.normal(next(ks), shape, jnp.float32) * scale

    def gain(shape):
        return 1.0 + nrm(shape, 0.02)

    L, D = DEPTH, D_MODEL
    x = nrm((BATCH, SEQ, D), 1.0)
    mem = nrm((BATCH, MEM_LEN, D), 1.0)
    ffn1_w_in = nrm((L, D, 2 * D_FF), D ** -0.5)
    ffn1_w_out = nrm((L, D_FF, D), BETA * D_FF ** -0.5)
    ln_ffn1_g = gain((L, D))
    ln_ffn1_b = nrm((L, D), 0.02)
    w_in = jnp.concatenate([
        nrm((L, D, 2 * A_WIDTH), D ** -0.5),
        nrm((L, D, A_WIDTH), BETA * D ** -0.5),
        nrm((L, D, Q_LORA + KV_LORA + QK_ROPE), D ** -0.5),
        nrm((L, D, N_BRANCH * D), D ** -0.5),
    ], axis=-1)
    gate_bias = nrm((L, N_BRANCH * D), 0.02)
    rel_bias = nrm((L, A_HEADS, 2 * MAX_REL + 1), 0.3)
    q_a_norm = gain((L, Q_LORA))
    w_q_b = nrm((L, Q_LORA, B_HEADS * (QK_NOPE + QK_ROPE)), Q_LORA ** -0.5)
    kv_a_norm = gain((L, KV_LORA))
    kv_scale = jnp.concatenate([jnp.ones((QK_NOPE,), jnp.float32), jnp.full((V_HEAD,), BETA, jnp.float32)])
    w_kv_b = (nrm((L, KV_LORA, B_HEADS, QK_NOPE + V_HEAD), KV_LORA ** -0.5) * kv_scale
              ).reshape(L, KV_LORA, B_HEADS * (QK_NOPE + V_HEAD))
    w_o_a = nrm((L, A_WIDTH, D), BETA * A_WIDTH ** -0.5)
    w_o_b = nrm((L, B_WIDTH, D), BETA * B_WIDTH ** -0.5)
    w_out = nrm((L, D, D), BETA * D ** -0.5)
    ln_mix_g = gain((L, D))
    ln_mix_b = nrm((L, D), 0.02)
    mem_ln_g = gain((L, D))
    mem_ln_b = nrm((L, D), 0.02)
    w_xq = nrm((L, D, D), D ** -0.5)
    xkv_scale = jnp.array([1.0, BETA], jnp.float32)[:, None, None]
    w_xkv = (nrm((L, D, 2, X_HEADS, X_HEAD_DIM), D ** -0.5) * xkv_scale).reshape(L, D, 2 * D)
    w_xo = nrm((L, D, D), BETA * D ** -0.5)
    ln_x_g = gain((L, D))
    ln_x_b = nrm((L, D), 0.02)
    ffn2_w_in = nrm((L, D, 2 * D_FF), D ** -0.5)
    ffn2_w_out = nrm((L, D_FF, D), BETA * D_FF ** -0.5)
    ln_ffn2_g = gain((L, D))
    ln_ffn2_b = nrm((L, D), 0.02)
    return {'x': x, 'mem': mem,
            'ffn1_w_in': ffn1_w_in, 'ffn1_w_out': ffn1_w_out, 'ln_ffn1_g': ln_ffn1_g, 'ln_ffn1_b': ln_ffn1_b,
            'w_in': w_in, 'gate_bias': gate_bias, 'rel_bias': rel_bias,
            'q_a_norm': q_a_norm, 'w_q_b': w_q_b, 'kv_a_norm': kv_a_norm, 'w_kv_b': w_kv_b,
            'w_o_a': w_o_a, 'w_o_b': w_o_b, 'w_out': w_out, 'ln_mix_g': ln_mix_g, 'ln_mix_b': ln_mix_b,
            'mem_ln_g': mem_ln_g, 'mem_ln_b': mem_ln_b, 'w_xq': w_xq, 'w_xkv': w_xkv, 'w_xo': w_xo,
            'ln_x_g': ln_x_g, 'ln_x_b': ln_x_b,
            'ffn2_w_in': ffn2_w_in, 'ffn2_w_out': ffn2_w_out, 'ln_ffn2_g': ln_ffn2_g, 'ln_ffn2_b': ln_ffn2_b}


def reference(x, mem, ffn1_w_in, ffn1_w_out, ln_ffn1_g, ln_ffn1_b,
              w_in, gate_bias, rel_bias, q_a_norm, w_q_b, kv_a_norm, w_kv_b,
              w_o_a, w_o_b, w_out, ln_mix_g, ln_mix_b,
              mem_ln_g, mem_ln_b, w_xq, w_xkv, w_xo, ln_x_g, ln_x_b,
              ffn2_w_in, ffn2_w_out, ln_ffn2_g, ln_ffn2_b):
    cos, sin = rope_tables(x.shape[1], QK_ROPE)
    h = x
    for l in range(DEPTH):
        h = layer_norm(ALPHA * h + 0.5 * swiglu_ffn(h, ffn1_w_in[l], ffn1_w_out[l]), ln_ffn1_g[l], ln_ffn1_b[l])
        mix = hybrid_mixer(h, w_in[l], gate_bias[l], rel_bias[l], q_a_norm[l], w_q_b[l], kv_a_norm[l],
                           w_kv_b[l], w_o_a[l], w_o_b[l], w_out[l], cos, sin)
        h = layer_norm(ALPHA * h + mix, ln_mix_g[l], ln_mix_b[l])
        xa = memory_cross_attention(h, mem, mem_ln_g[l], mem_ln_b[l], w_xq[l], w_xkv[l], w_xo[l])
        h = layer_norm(ALPHA * h + xa, ln_x_g[l], ln_x_b[l])
        h = layer_norm(ALPHA * h + 0.5 * swiglu_ffn(h, ffn2_w_in[l], ffn2_w_out[l]), ln_ffn2_g[l], ln_ffn2_b[l])
    return h
```

```cpp
#include <hip/hip_runtime.h>
#include <hip/hip_cooperative_groups.h>
#include <cstdio>
#include <cstdint>
#include <cstring>
namespace cg = cooperative_groups;

#define LAS __attribute__((address_space(3)))
typedef unsigned short bf16_t;
typedef short bf16x8 __attribute__((ext_vector_type(8)));
typedef float f32x4 __attribute__((ext_vector_type(4)));
typedef float f32x2 __attribute__((ext_vector_type(2)));
typedef unsigned u32x4 __attribute__((ext_vector_type(4)));
typedef unsigned u32x2 __attribute__((ext_vector_type(2)));

constexpr int T_ = 16384, D_ = 2048, S_ = 4096, DFF_ = 5504;
constexpr float ALPHA_ = 1.1892071150027210667f;
constexpr float LOG2E_ = 1.4426950408889634f;
constexpr int LDS_BYTES = 147456;
#ifndef EPIMASK
#define EPIMASK 255
#endif
#define EPIM(e) ((EPIMASK >> (e)) & 1)
#ifndef PHM
#define PHM 63
#endif

enum { E_BF16 = 0, E_LAT, E_GATES, E_SWIGLU, E_RESZ, E_ROPEQ, E_DUAL0, E_DUAL1 };
enum { K_PRO = 0, K_GEMM, K_DUAL, K_LN, K_PREPA, K_MLA, K_XATTN };

struct Prob {
    const bf16_t* A; const bf16_t* B; void* out; const void* aux; const void* aux2;
    int nM, nN, nt, epi, ldo; float f0, f1; int pad;
};
struct Phase { int kind, p0, np, ld, arg, pad0, pad1, pad2; };
struct CJob { const float* W; bf16_t* dst; const float* ksc; int K, N, ldd, mode, ntiles, pad; };
struct Params {
    const float* in[29];
    float* out;
    unsigned char* ws;
    float* z; bf16_t* hb; float* lat; float* kraw; bf16_t* cq; bf16_t* ckv; bf16_t* kpe; bf16_t* memb;
    bf16_t* qka; bf16_t* vta; bf16_t* kn; bf16_t* qr; bf16_t* vtb; bf16_t* gates; bf16_t* xq; bf16_t* ox; bf16_t* kx; bf16_t* vtx;
    float* cosT; float* sinT; bf16_t* wmix;
    int nphase, njob0, njob1, pad;
    Phase ph[20];
    Prob pr[20];
    CJob job[13];
};

static_assert(sizeof(Params) <= 4000, "kernel argument too large");
typedef const Params __attribute__((address_space(4)))* PP;

__device__ __forceinline__ unsigned cvt_pk_bf16(float lo, float hi) { unsigned r; asm volatile("v_cvt_pk_bf16_f32 %0, %1, %2" : "=v"(r) : "v"(lo), "v"(hi)); return r; }
__device__ __forceinline__ float bf_lo(unsigned w) { return __uint_as_float(w << 16); }
__device__ __forceinline__ float bf_hi(unsigned w) { return __uint_as_float(w & 0xffff0000u); }
__device__ __forceinline__ float wave_sum(float v) {
#pragma unroll
    for (int o = 1; o < 64; o <<= 1) v += __shfl_xor(v, o);
    return v;
}
__device__ __forceinline__ float fast_exp2(float x) { return __builtin_amdgcn_exp2f(x); }
__device__ __forceinline__ float sigmoidf_(float x) { return 1.0f / (1.0f + __expf(-x)); }

constexpr int BM = 256, BK = 64, HALF = 128, HTB = HALF * BK * 2;
__host__ __device__ __forceinline__ int lds_byte(int r, int c) { const int st = (r >> 4) * 2 + (c >> 5), rr = r & 15, cc = c & 31, ob = rr * 64 + cc * 2; return st * 1024 + (ob ^ (((ob >> 9) & 1) << 5)); }
__host__ __device__ __forceinline__ void stage_rc(int b, int& R, int& C) { const int st = b / 1024, sb = b % 1024, swz = sb ^ (((sb >> 9) & 1) << 5); R = (st >> 1) * 16 + swz / 64; C = (st & 1) * 32 + (swz % 64) / 2; }

struct GU { const char* A; const char* B; int nt, pm, pn, pi; };
__device__ __forceinline__ const char* uni_ptr(const char* p) { const unsigned long long v = (unsigned long long)p; const unsigned lo = __builtin_amdgcn_readfirstlane((unsigned)v), hi = __builtin_amdgcn_readfirstlane((unsigned)(v >> 32)); return (const char*)(((unsigned long long)hi << 32) | lo); }

__device__ __forceinline__ bool g_next(PP P, const Phase& ph, int i, GU& u) {
    const int G = gridDim.x, c = blockIdx.x;
    const bool dual = ph.kind == K_DUAL;
    const int ti = dual ? (i >> 1) : i;
    long L = (long)ti * G + c;
    int pi = ph.p0; bool found = false;
    const int np = dual ? 1 : ph.np;
    for (int k = 0; k < np; ++k) { const int cnt = P->pr[pi].nM * P->pr[pi].nN; if (L < cnt) { found = true; break; } L -= cnt; ++pi; }
    if (!__builtin_amdgcn_readfirstlane((int)found)) return false;
    L = __builtin_amdgcn_readfirstlane((int)L); pi = __builtin_amdgcn_readfirstlane(pi);
    const int nM = P->pr[pi].nM, nN = P->pr[pi].nN, nwg = nM * nN;
    int wgid = (int)L; { const int q = nwg / 8, r = nwg % 8, xcd = wgid % 8, off = wgid / 8; wgid = (xcd < r ? xcd * (q + 1) : r * (q + 1) + (xcd - r) * q) + off; }
    const int nig = 8 * nN, gid = wgid / nig, fm = gid * 8, gsz = (nM - fm) < 8 ? (nM - fm) : 8;
    u.pm = __builtin_amdgcn_readfirstlane(fm + ((wgid % nig) % gsz)); u.pn = __builtin_amdgcn_readfirstlane((wgid % nig) / gsz);
    if (dual) pi += (i & 1);
    pi = __builtin_amdgcn_readfirstlane(pi);
    u.pi = pi;
    const size_t tstep = (size_t)BM * ph.ld * 2;
    u.A = uni_ptr((const char*)P->pr[pi].A + (size_t)u.pm * tstep); u.B = uni_ptr((const char*)P->pr[pi].B + (size_t)u.pn * tstep); u.nt = __builtin_amdgcn_readfirstlane(P->pr[pi].nt);
    return true;
}

__device__ __forceinline__ void g_epi(PP P, const GU& u, f32x4 (&acc)[2][2][4][2], int wr, int wc, int fr, int fq) {
#define pr (P->pr[u.pi])
#ifdef EPIFORCE
    const int epi = EPIFORCE;
#else
    const int epi = pr.epi;
#endif
    const int rowb = u.pm * BM + wr * 64 + fr;
    const int colb = u.pn * BM + wc * 32 + fq * 4;
    if (epi == E_BF16) {
        bf16_t* O = (bf16_t*)pr.out; const int ldo = pr.ldo;
#pragma unroll
        for (int ai = 0; ai < 2; ++ai)
#pragma unroll
            for (int m = 0; m < 4; ++m) { asm volatile("" ::: "memory"); bf16_t* rp = O + (size_t)(rowb + ai * HALF + m * 16) * ldo + colb;
#pragma unroll
                for (int bj = 0; bj < 2; ++bj)
#pragma unroll
                    for (int n = 0; n < 2; ++n) { const f32x4 v = acc[ai][bj][m][n]; u32x2 w; w.x = cvt_pk_bf16(v[0], v[1]); w.y = cvt_pk_bf16(v[2], v[3]); *(u32x2*)(rp + bj * HALF + n * 16) = w; } }
    } else if (EPIM(E_LAT) && epi == E_LAT) {
        if (u.pn < 4) {
            float* O = (float*)pr.out;
#pragma unroll
            for (int ai = 0; ai < 2; ++ai)
#pragma unroll
                for (int m = 0; m < 4; ++m) { asm volatile("" ::: "memory"); float* rp = O + (size_t)(rowb + ai * HALF + m * 16) * 1024 + colb;
#pragma unroll
                    for (int bj = 0; bj < 2; ++bj)
#pragma unroll
                        for (int n = 0; n < 2; ++n) *(f32x4*)(rp + bj * HALF + n * 16) = acc[ai][bj][m][n]; }
        } else if (wc < 2) {
            float* O = (float*)pr.aux2;
#pragma unroll
            for (int ai = 0; ai < 2; ++ai)
#pragma unroll
                for (int m = 0; m < 4; ++m) { asm volatile("" ::: "memory"); float* rp = O + (size_t)(rowb + ai * HALF + m * 16) * 64 + wc * 32 + fq * 4;
#pragma unroll
                    for (int n = 0; n < 2; ++n) *(f32x4*)(rp + n * 16) = acc[ai][0][m][n]; }
        }
    } else if (EPIM(E_GATES) && epi == E_GATES) {
        bf16_t* O = (bf16_t*)pr.out; const float* bias = (const float*)pr.aux;
#pragma unroll
        for (int bj = 0; bj < 2; ++bj)
#pragma unroll
            for (int n = 0; n < 2; ++n) { const f32x4 bv = *(const f32x4*)(bias + colb + bj * HALF + n * 16);
#pragma unroll
                for (int ai = 0; ai < 2; ++ai)
#pragma unroll
                    for (int m = 0; m < 4; ++m) { asm volatile("" ::: "memory"); const f32x4 v = acc[ai][bj][m][n] + bv; u32x2 w; w.x = cvt_pk_bf16(sigmoidf_(v[0]), sigmoidf_(v[1])); w.y = cvt_pk_bf16(sigmoidf_(v[2]), sigmoidf_(v[3]));
                        *(u32x2*)(O + (size_t)(rowb + ai * HALF + m * 16) * 4096 + colb + bj * HALF + n * 16) = w; } }
    } else if (EPIM(E_SWIGLU) && epi == E_SWIGLU) {
        bf16_t* O = (bf16_t*)pr.out; const int cb = u.pn * 128 + wc * 32 + fq * 4;
#pragma unroll
        for (int ai = 0; ai < 2; ++ai)
#pragma unroll
            for (int m = 0; m < 4; ++m) { asm volatile("" ::: "memory"); bf16_t* rp = O + (size_t)(rowb + ai * HALF + m * 16) * DFF_ + cb;
#pragma unroll
                for (int n = 0; n < 2; ++n) { const f32x4 g = acc[ai][0][m][n], uu = acc[ai][1][m][n]; f32x4 v;
#pragma unroll
                    for (int j = 0; j < 4; ++j) v[j] = g[j] * sigmoidf_(g[j]) * uu[j];
                    u32x2 w; w.x = cvt_pk_bf16(v[0], v[1]); w.y = cvt_pk_bf16(v[2], v[3]); *(u32x2*)(rp + n * 16) = w; } }
    } else if (EPIM(E_RESZ) && epi == E_RESZ) {
        float* O = (float*)pr.out; const float* R = (const float*)pr.aux; const float f0 = pr.f0, f1 = pr.f1;
#pragma unroll
        for (int ai = 0; ai < 2; ++ai)
#pragma unroll
            for (int m = 0; m < 4; ++m) { asm volatile("" ::: "memory"); const size_t off = (size_t)(rowb + ai * HALF + m * 16) * D_ + colb;
#pragma unroll
                for (int bj = 0; bj < 2; ++bj)
#pragma unroll
                    for (int n = 0; n < 2; ++n) { const f32x4 r = *(const f32x4*)(R + off + bj * HALF + n * 16); *(f32x4*)(O + off + bj * HALF + n * 16) = r * f0 + acc[ai][bj][m][n] * f1; } }
    } else if (EPIM(E_ROPEQ) && epi == E_ROPEQ) {
        bf16_t* O = (bf16_t*)pr.out; const float* cT = (const float*)pr.aux; const float* sT = (const float*)pr.aux2;
        const int head = u.pn * 4 + wc;
#pragma unroll
        for (int ai = 0; ai < 2; ++ai)
#pragma unroll
            for (int m = 0; m < 4; ++m) { asm volatile("" ::: "memory"); const int row = rowb + ai * HALF + m * 16; const int pos = row & (S_ - 1);
#pragma unroll
                for (int n = 0; n < 2; ++n) { const int ri = n * 16 + fq * 4; const f32x4 cs = *(const f32x4*)(cT + pos * 32 + ri), sn = *(const f32x4*)(sT + pos * 32 + ri);
                    const f32x4 x1 = acc[ai][0][m][n], x2 = acc[ai][1][m][n]; const f32x4 o1 = x1 * cs - x2 * sn, o2 = x2 * cs + x1 * sn;
                    u32x2 w1, w2; w1.x = cvt_pk_bf16(o1[0], o1[1]); w1.y = cvt_pk_bf16(o1[2], o1[3]); w2.x = cvt_pk_bf16(o2[0], o2[1]); w2.y = cvt_pk_bf16(o2[2], o2[3]);
                    bf16_t* rp = O + (size_t)row * 1024 + head * 64 + ri; *(u32x2*)rp = w1; *(u32x2*)(rp + 32) = w2; } }
    } else if (EPIM(E_DUAL0) && epi == E_DUAL0) {
        const bf16_t* G = (const bf16_t*)pr.aux; bf16_t* O = (bf16_t*)pr.out;
#pragma unroll
        for (int ai = 0; ai < 2; ++ai)
#pragma unroll
            for (int m = 0; m < 4; ++m) { asm volatile("" ::: "memory"); const size_t ro = (size_t)(rowb + ai * HALF + m * 16);
#pragma unroll
                for (int bj = 0; bj < 2; ++bj)
#pragma unroll
                    for (int n = 0; n < 2; ++n) { const u32x2 ga = *(const u32x2*)(G + ro * 4096 + colb + bj * HALF + n * 16); const f32x4 v = acc[ai][bj][m][n];
                        u32x2 w; w.x = cvt_pk_bf16(v[0] * bf_lo(ga.x), v[1] * bf_hi(ga.x)); w.y = cvt_pk_bf16(v[2] * bf_lo(ga.y), v[3] * bf_hi(ga.y));
                        *(u32x2*)(O + ro * D_ + colb + bj * HALF + n * 16) = w; } }
    } else if (EPIM(E_DUAL1) && epi == E_DUAL1) {
        const bf16_t* G = (const bf16_t*)pr.aux; bf16_t* O = (bf16_t*)pr.out; const bf16_t* Tm = (const bf16_t*)pr.aux2;
#pragma unroll
        for (int ai = 0; ai < 2; ++ai)
#pragma unroll
            for (int m = 0; m < 4; ++m) { asm volatile("" ::: "memory"); const size_t ro = (size_t)(rowb + ai * HALF + m * 16);
#pragma unroll
                for (int bj = 0; bj < 2; ++bj)
#pragma unroll
                    for (int n = 0; n < 2; ++n) { const u32x2 gb = *(const u32x2*)(G + ro * 4096 + 2048 + colb + bj * HALF + n * 16); const u32x2 tv = *(const u32x2*)(Tm + ro * D_ + colb + bj * HALF + n * 16); const f32x4 v = acc[ai][bj][m][n];
                        u32x2 w; w.x = cvt_pk_bf16(bf_lo(tv.x) + v[0] * bf_lo(gb.x), bf_hi(tv.x) + v[1] * bf_hi(gb.x)); w.y = cvt_pk_bf16(bf_lo(tv.y) + v[2] * bf_lo(gb.y), bf_hi(tv.y) + v[3] * bf_hi(gb.y));
                        *(u32x2*)(O + ro * D_ + colb + bj * HALF + n * 16) = w; } }
    }
}

#undef pr
__device__ __forceinline__ void gemm_phase(LAS unsigned char* lds, PP P, const Phase& ph, const int tid) {
    const int wid = __builtin_amdgcn_readfirstlane(tid >> 6), lane = tid & 63, wr = wid >> 2, wc = wid & 3, fr = lane & 15, fq = lane >> 4;
    const int ld = ph.ld;
    unsigned voff[2];
#pragma unroll
    for (int i = 0; i < 2; ++i) { int R, C; stage_rc(tid * 16 + i * 8192, R, C); voff[i] = (unsigned)(R * ld + C) * 2u; }
    const size_t kstep = (size_t)(BK * 2);
    const size_t hstep = (size_t)HALF * ld * 2;
    const unsigned ldsw = (unsigned)wid * 1024u;
    const int aoff = lds_byte(wr * 64 + fr, fq * 8), boff = lds_byte(wc * 32 + fr, fq * 8);
#define PG8_SA(b, h) (((b) * 2 + (h)) * HTB)
#define PG8_SB(b, h) ((4 + (b) * 2 + (h)) * HTB)
#define PG8_STAGE(bufoff, gbase) do { _Pragma("unroll") for (int _i = 0; _i < 2; ++_i) \
        __builtin_amdgcn_global_load_lds((const unsigned*)((const char*)(gbase) + voff[_i]), (LAS unsigned*)(lds + (bufoff) + ldsw + _i * 8192), 16, 0, 0); } while (0)
#define PG8_LDA(dst, b, h) do { _Pragma("unroll") for (int m = 0; m < 4; ++m) _Pragma("unroll") for (int k = 0; k < 2; ++k) dst[m][k] = *(const LAS bf16x8*)(lds + PG8_SA(b, h) + aoff + m * 2048 + k * 1024); } while (0)
#define PG8_LDB(dst, b, h) do { _Pragma("unroll") for (int n = 0; n < 2; ++n) _Pragma("unroll") for (int k = 0; k < 2; ++k) dst[n][k] = *(const LAS bf16x8*)(lds + PG8_SB(b, h) + boff + n * 2048 + k * 1024); } while (0)
#define PG8_MMA(ai, bj, At, Bt) do { __builtin_amdgcn_s_setprio(1); _Pragma("unroll") for (int m = 0; m < 4; ++m) _Pragma("unroll") for (int n = 0; n < 2; ++n) _Pragma("unroll") for (int k = 0; k < 2; ++k) \
        acc[ai][bj][m][n] = __builtin_amdgcn_mfma_f32_16x16x32_bf16(Bt[n][k], At[m][k], acc[ai][bj][m][n], 0, 0, 0); __builtin_amdgcn_s_setprio(0); } while (0)
#define PG8_WAIT_V(n) asm volatile("s_waitcnt vmcnt(" #n ")" ::: "memory")
#define PG8_WAIT_L(n) asm volatile("s_waitcnt lgkmcnt(" #n ")" ::: "memory")
#define PG8_BAR __builtin_amdgcn_s_barrier()
#define PG8_SCHED __builtin_amdgcn_sched_barrier(0)
    GU cur, nxt; int ui = 0;
    if (!g_next(P, ph, 0, cur)) return;
    f32x4 acc[2][2][4][2];
#pragma unroll
    for (int a = 0; a < 2; ++a)
#pragma unroll
        for (int b = 0; b < 2; ++b)
#pragma unroll
            for (int m = 0; m < 4; ++m)
#pragma unroll
                for (int n = 0; n < 2; ++n) acc[a][b][m][n] = (f32x4){0.f, 0.f, 0.f, 0.f};
    bf16x8 At[4][2], B0[2][2], B1[2][2];
    const char* cA = cur.A; const char* cB = cur.B;
    PG8_STAGE(PG8_SB(0, 0), cB); PG8_STAGE(PG8_SB(0, 1), cB + hstep); PG8_STAGE(PG8_SA(0, 0), cA); PG8_STAGE(PG8_SA(0, 1), cA + hstep);
    if (wr == 1) PG8_BAR;
    PG8_WAIT_V(2); PG8_BAR;
    PG8_STAGE(PG8_SB(1, 0), cB + kstep); PG8_STAGE(PG8_SA(1, 0), cA + kstep); PG8_STAGE(PG8_SB(1, 1), cB + hstep + kstep);
    PG8_WAIT_V(6); PG8_BAR;
    for (;;) {
        const bool has_next = g_next(P, ph, ui + 1, nxt);
        const char* nA = has_next ? nxt.A : cA; const char* nB = has_next ? nxt.B : cB;
        const int nt = cur.nt;
        for (int t = 0; t < nt; t += 2) {
            const bool last = (t == nt - 2);
            const char* a1 = cA + (size_t)(t + 1) * kstep;
            const char* a2 = last ? nA : cA + (size_t)(t + 2) * kstep; const char* b2 = last ? nB : cB + (size_t)(t + 2) * kstep;
            const char* a3 = a2 + kstep; const char* b3 = b2 + kstep;
            PG8_LDB(B0, 0, 0); PG8_LDB(B1, 0, 1); PG8_SCHED; PG8_LDA(At, 0, 0); PG8_STAGE(PG8_SA(1, 1), a1 + hstep);
            PG8_WAIT_V(8); PG8_WAIT_L(0); PG8_BAR; PG8_MMA(0, 0, At, B0); PG8_MMA(0, 1, At, B1); PG8_BAR; PG8_SCHED;
            PG8_LDA(At, 0, 1); PG8_STAGE(PG8_SB(0, 0), b2); PG8_STAGE(PG8_SB(0, 1), b2 + hstep); PG8_STAGE(PG8_SA(0, 0), a2);
            PG8_WAIT_V(8); PG8_WAIT_L(0); PG8_BAR; PG8_MMA(1, 0, At, B0); PG8_MMA(1, 1, At, B1); PG8_BAR; PG8_SCHED;
            PG8_LDB(B0, 1, 0); PG8_LDB(B1, 1, 1); PG8_SCHED; PG8_LDA(At, 1, 0); PG8_STAGE(PG8_SA(0, 1), a2 + hstep);
            PG8_WAIT_V(8); PG8_WAIT_L(0); PG8_BAR; PG8_MMA(0, 0, At, B0); PG8_MMA(0, 1, At, B1); PG8_BAR; PG8_SCHED;
            PG8_LDA(At, 1, 1); PG8_STAGE(PG8_SB(1, 0), b3); PG8_STAGE(PG8_SB(1, 1), b3 + hstep); PG8_STAGE(PG8_SA(1, 0), a3);
            PG8_WAIT_V(8); PG8_WAIT_L(0); PG8_BAR; PG8_MMA(1, 0, At, B0); PG8_MMA(1, 1, At, B1); PG8_BAR; PG8_SCHED;
        }
        if (wr == 0) PG8_BAR;
        g_epi(P, cur, acc, wr, wc, fr, fq);
        if (!has_next) break;
#pragma unroll
        for (int a = 0; a < 2; ++a)
#pragma unroll
            for (int b = 0; b < 2; ++b)
#pragma unroll
                for (int m = 0; m < 4; ++m)
#pragma unroll
                    for (int n = 0; n < 2; ++n) acc[a][b][m][n] = (f32x4){0.f, 0.f, 0.f, 0.f};
        cur = nxt; cA = nA; cB = nB; ++ui;
        if (wr == 1) PG8_BAR;
    }
    PG8_WAIT_V(0);
    PG8_BAR;
#undef PG8_SA
#undef PG8_SB
#undef PG8_STAGE
#undef PG8_LDA
#undef PG8_LDB
#undef PG8_MMA
}

template <int DQK, int DV, int W1, int QB, bool PF, bool BIAS>
__device__ __forceinline__ void attn_unit(LAS unsigned char* lds, const bf16_t* Q1, int ldq1, const bf16_t* Q2, int ldq2,
                                          const bf16_t* K1, int ldk1, const bf16_t* K2, int ldk2, const bf16_t* Vt, int ldv, bf16_t* O, int ldo,
                                          int tlo, int thi, int wlo, int whi, float scale2, int qpos_w, const float* rbias, const int tid) {
    constexpr int KS = DQK * 2 + 16, KBYTES = 64 * KS, VS = 144, VBYTES = DV * VS, NBUF = PF ? 2 : 1;
    constexpr int KC = DQK / 64, VC = DV / 64, NKS = DQK / 32, NDB = DV / 16, CPR = DQK / 8;
    const int wid = __builtin_amdgcn_readfirstlane(tid >> 6), lane = tid & 63, fr = lane & 15, fq = lane >> 4;
    LAS unsigned char* kbase = lds;
    LAS unsigned char* vbase = lds + NBUF * KBYTES;
    LAS float* rb = (LAS float*)(lds + NBUF * (KBYTES + VBYTES));
    if (BIAS) { if (tid < 257) rb[tid] = rbias[tid] * LOG2E_; }
    bf16x8 qf[QB][NKS];
#pragma unroll
    for (int qb = 0; qb < QB; ++qb) { const int row = wid * 16 * QB + qb * 16 + fr;
#pragma unroll
        for (int ks = 0; ks < NKS; ++ks) { const int col = ks * 32 + fq * 8;
            qf[qb][ks] = (col < W1) ? *(const bf16x8*)(Q1 + (size_t)row * ldq1 + col) : *(const bf16x8*)(Q2 + (size_t)row * ldq2 + (col - W1)); } }
    f32x4 oacc[QB][NDB];
    float mrun[QB], lrun[QB];
#pragma unroll
    for (int qb = 0; qb < QB; ++qb) { mrun[qb] = -1e30f; lrun[qb] = 0.f;
#pragma unroll
        for (int db = 0; db < NDB; ++db) oacc[qb][db] = (f32x4){0.f, 0.f, 0.f, 0.f}; }
    bf16x8 kreg[KC], vreg[VC];
#define ATT_LOADK(kt) do { \
        _Pragma("unroll") for (int i = 0; i < KC; ++i) { const int ci = tid + 512 * i, row = ci / CPR, col = (ci % CPR) * 8; const size_t key = (size_t)(kt) * 64 + row; \
            kreg[i] = (col < W1) ? *(const bf16x8*)(K1 + key * ldk1 + col) : *(const bf16x8*)(K2 + key * ldk2 + (col - W1)); } } while (0)
#define ATT_LOADV(kt) do { \
        _Pragma("unroll") for (int i = 0; i < VC; ++i) { const int ci = tid + 512 * i, row = ci >> 3, cc = ci & 7; vreg[i] = *(const bf16x8*)(Vt + (size_t)row * ldv + (size_t)(kt) * 64 + cc * 8); } } while (0)
#define ATT_STOREK(buf) do { \
        _Pragma("unroll") for (int i = 0; i < KC; ++i) { const int ci = tid + 512 * i, row = ci / CPR, cc = ci % CPR; *(LAS bf16x8*)(kbase + (buf) * KBYTES + row * KS + cc * 16) = kreg[i]; } } while (0)
#define ATT_STOREV(buf) do { \
        _Pragma("unroll") for (int i = 0; i < VC; ++i) { const int ci = tid + 512 * i, row = ci >> 3, cc = ci & 7; *(LAS bf16x8*)(vbase + (buf) * VBYTES + row * VS + cc * 16) = vreg[i]; } } while (0)
#define ATT_LOAD(kt) do { ATT_LOADK(kt); ATT_LOADV(kt); } while (0)
#define ATT_STORE(buf) do { ATT_STOREK(buf); ATT_STOREV(buf); } while (0)
    if (PF) { ATT_LOAD(tlo); ATT_STORE(0); __syncthreads(); }
    for (int kt = tlo; kt < thi; ++kt) {
        const int cur = PF ? ((kt - tlo) & 1) : 0;
        if (PF) { if (kt + 1 < thi) ATT_LOAD(kt + 1); }
        else { __syncthreads(); ATT_LOADK(kt); ATT_STOREK(0); ATT_LOADV(kt); ATT_STOREV(0); __syncthreads(); }
        if (kt >= wlo && kt < whi) {
            const LAS unsigned char* kb_ = kbase + cur * KBYTES;
            const LAS unsigned char* vb_ = vbase + cur * VBYTES;
            f32x4 sacc[QB][4];
#pragma unroll
            for (int qb = 0; qb < QB; ++qb)
#pragma unroll
                for (int kb = 0; kb < 4; ++kb) sacc[qb][kb] = (f32x4){0.f, 0.f, 0.f, 0.f};
#pragma unroll
            for (int ks = 0; ks < NKS; ++ks)
#pragma unroll
                for (int kb = 0; kb < 4; ++kb) { const bf16x8 kf = *(const LAS bf16x8*)(kb_ + (kb * 16 + fr) * KS + ks * 64 + fq * 16);
#pragma unroll
                    for (int qb = 0; qb < QB; ++qb) sacc[qb][kb] = __builtin_amdgcn_mfma_f32_16x16x32_bf16(kf, qf[qb][ks], sacc[qb][kb], 0, 0, 0); }
            bf16x8 pf[QB][2];
#pragma unroll
            for (int qb = 0; qb < QB; ++qb) {
                float mx = -3e38f;
#pragma unroll
                for (int kb = 0; kb < 4; ++kb)
#pragma unroll
                    for (int j = 0; j < 4; ++j) { float s = sacc[qb][kb][j] * scale2;
                        if (BIAS) { int dist = (qpos_w + qb * 16 + fr) - (kt * 64 + kb * 16 + fq * 4 + j); dist = dist < -128 ? -128 : (dist > 128 ? 128 : dist); s += rb[dist + 128]; }
                        sacc[qb][kb][j] = s; mx = fmaxf(mx, s); }
                mx = fmaxf(mx, __shfl_xor(mx, 16)); mx = fmaxf(mx, __shfl_xor(mx, 32));
                const float mn = fmaxf(mrun[qb], mx); const float al = fast_exp2(mrun[qb] - mn); mrun[qb] = mn;
                float ps = 0.f;
#pragma unroll
                for (int kb = 0; kb < 4; ++kb)
#pragma unroll
                    for (int j = 0; j < 4; ++j) { const float p = fast_exp2(sacc[qb][kb][j] - mn); sacc[qb][kb][j] = p; ps += p; }
                lrun[qb] = lrun[qb] * al + ps;
#pragma unroll
                for (int db = 0; db < NDB; ++db) oacc[qb][db] = oacc[qb][db] * al;
#pragma unroll
                for (int ks = 0; ks < 2; ++ks) { u32x4 w; w.x = cvt_pk_bf16(sacc[qb][2 * ks][0], sacc[qb][2 * ks][1]); w.y = cvt_pk_bf16(sacc[qb][2 * ks][2], sacc[qb][2 * ks][3]);
                    w.z = cvt_pk_bf16(sacc[qb][2 * ks + 1][0], sacc[qb][2 * ks + 1][1]); w.w = cvt_pk_bf16(sacc[qb][2 * ks + 1][2], sacc[qb][2 * ks + 1][3]);
                    pf[qb][ks] = __builtin_bit_cast(bf16x8, w); }
            }
#pragma unroll
            for (int db = 0; db < NDB; ++db)
#pragma unroll
                for (int ks = 0; ks < 2; ++ks) { const LAS unsigned char* vp = vb_ + (db * 16 + fr) * VS + ks * 64 + fq * 8;
                    const u32x2 v0 = *(const LAS u32x2*)vp, v1 = *(const LAS u32x2*)(vp + 32); u32x4 w; w.x = v0.x; w.y = v0.y; w.z = v1.x; w.w = v1.y;
                    const bf16x8 vf = __builtin_bit_cast(bf16x8, w);
#pragma unroll
                    for (int qb = 0; qb < QB; ++qb) oacc[qb][db] = __builtin_amdgcn_mfma_f32_16x16x32_bf16(vf, pf[qb][ks], oacc[qb][db], 0, 0, 0); }
        }
        if (PF) { if (kt + 1 < thi) ATT_STORE(cur ^ 1); __syncthreads(); }
    }
    if (!PF) __syncthreads();
#pragma unroll
    for (int qb = 0; qb < QB; ++qb) { float l = lrun[qb]; l += __shfl_xor(l, 16); l += __shfl_xor(l, 32); const float inv = 1.0f / l;
        bf16_t* rp = O + (size_t)(wid * 16 * QB + qb * 16 + fr) * ldo + fq * 4;
#pragma unroll
        for (int db = 0; db < NDB; ++db) { const f32x4 v = oacc[qb][db] * inv; u32x2 w; w.x = cvt_pk_bf16(v[0], v[1]); w.y = cvt_pk_bf16(v[2], v[3]); *(u32x2*)(rp + db * 16) = w; } }
#undef ATT_LOAD
#undef ATT_STORE
#undef ATT_LOADK
#undef ATT_LOADV
#undef ATT_STOREK
#undef ATT_STOREV
}

__device__ __forceinline__ int map_row(int mode, int c) {
    if (mode == 1) { const int bj = c / DFF_, q = c % DFF_; return (q >> 7) * 256 + bj * 128 + (q & 127); }
    if (mode == 2) return c < 4160 ? c : c + 192;
    if (mode == 3) { const int h = c / 192, r = c % 192; if (r < 128) return h * 128 + r; const int rr = r - 128; return 2048 + (h >> 2) * 256 + (rr >> 5) * 128 + (h & 3) * 32 + (rr & 31); }
    if (mode == 4) { const int h = c >> 8, r = c & 255; return r < 128 ? h * 128 + r : 2048 + h * 128 + (r - 128); }
    return c;
}

__device__ __forceinline__ void conv_jobs(LAS unsigned char* lds, PP P, int j0, int j1, const int tid) {
    LAS float* tile = (LAS float*)lds;
    const int t = tid;
    int total = 0;
    for (int j = j0; j < j1; ++j) total += P->job[j].ntiles;
    for (int it = blockIdx.x; it < total; it += gridDim.x) {
        int j = j0, l = it;
        while (l >= P->job[j].ntiles) { l -= P->job[j].ntiles; ++j; }
#define J (P->job[j])
        const int nct = J.N / 64; const int kt = l / nct, ct = l % nct; const int k0 = kt * 64, c0 = ct * 64;
#pragma unroll
        for (int i = 0; i < 2; ++i) { const int k = (t >> 4) + 32 * i, n4 = (t & 15) * 4; const f32x4 v = *(const f32x4*)(J.W + (size_t)(k0 + k) * J.N + c0 + n4);
            const float s = J.ksc ? J.ksc[k0 + k] : 1.0f;
            tile[k * 65 + n4 + 0] = v[0] * s; tile[k * 65 + n4 + 1] = v[1] * s; tile[k * 65 + n4 + 2] = v[2] * s; tile[k * 65 + n4 + 3] = v[3] * s; }
        __syncthreads();
        { const int n = t >> 3, k8 = (t & 7) * 8; const int row = map_row(J.mode, c0 + n);
          u32x4 w; w.x = cvt_pk_bf16(tile[(k8 + 0) * 65 + n], tile[(k8 + 1) * 65 + n]); w.y = cvt_pk_bf16(tile[(k8 + 2) * 65 + n], tile[(k8 + 3) * 65 + n]);
          w.z = cvt_pk_bf16(tile[(k8 + 4) * 65 + n], tile[(k8 + 5) * 65 + n]); w.w = cvt_pk_bf16(tile[(k8 + 6) * 65 + n], tile[(k8 + 7) * 65 + n]);
          *(u32x4*)(J.dst + (size_t)row * J.ldd + k0 + k8) = w; }
        __syncthreads();
    }
}

#undef J
__device__ __forceinline__ void ln_rows(const float* src, const float* g, const float* b, float* outf, bf16_t* outb, int nrows, const int tid) {
    const int wid = tid >> 6, lane = tid & 63;
    f32x4 gv[8], bv[8];
#pragma unroll
    for (int i = 0; i < 8; ++i) { gv[i] = *(const f32x4*)(g + (lane + 64 * i) * 4); bv[i] = *(const f32x4*)(b + (lane + 64 * i) * 4); }
    for (int row = blockIdx.x * 8 + wid; row < nrows; row += gridDim.x * 8) {
        const f32x4* p = (const f32x4*)(src + (size_t)row * D_);
        f32x4 v[8]; float s = 0.f;
#pragma unroll
        for (int i = 0; i < 8; ++i) { v[i] = p[lane + 64 * i]; s += (v[i][0] + v[i][1]) + (v[i][2] + v[i][3]); }
        const float mean = wave_sum(s) * (1.0f / D_);
        float q = 0.f;
#pragma unroll
        for (int i = 0; i < 8; ++i) { const f32x4 d = v[i] - mean; q += (d[0] * d[0] + d[1] * d[1]) + (d[2] * d[2] + d[3] * d[3]); }
        const float rstd = 1.0f / sqrtf(wave_sum(q) * (1.0f / D_) + 1e-5f);
#pragma unroll
        for (int i = 0; i < 8; ++i) { const f32x4 y = (v[i] - mean) * rstd * gv[i] + bv[i];
            if (outf) *(f32x4*)(outf + (size_t)row * D_ + (lane + 64 * i) * 4) = y;
            if (outb) { u32x2 w; w.x = cvt_pk_bf16(y[0], y[1]); w.y = cvt_pk_bf16(y[2], y[3]); *(u32x2*)(outb + (size_t)row * D_ + (lane + 64 * i) * 4) = w; } }
    }
}

__device__ __forceinline__ void prologue_misc(PP P, const int tid) {
    const size_t gt = (size_t)blockIdx.x * 512 + tid, gn = (size_t)gridDim.x * 512;
    { const float* x = P->in[0]; bf16_t* xb = P->hb;
      for (size_t i = gt; i < (size_t)T_ * D_ / 8; i += gn) { const f32x4 a = *(const f32x4*)(x + i * 8), b = *(const f32x4*)(x + i * 8 + 4);
          u32x4 w; w.x = cvt_pk_bf16(a[0], a[1]); w.y = cvt_pk_bf16(a[2], a[3]); w.z = cvt_pk_bf16(b[0], b[1]); w.w = cvt_pk_bf16(b[2], b[3]); *(u32x4*)(xb + i * 8) = w; } }
    for (size_t i = gt; i < (size_t)S_ * 32; i += gn) { const int pos = (int)(i >> 5), k = (int)(i & 31);
        const float inv = 1.0f / powf(10000.0f, (float)(2 * k) / 64.0f); const float ang = (float)pos * inv;
        const double a = (double)ang; const double kk = rint(a * 0.15915494309189533577); const float r = (float)(a - kk * 6.283185307179586476925);
        P->cosT[i] = cosf(r); P->sinT[i] = sinf(r); }
    { u32x4* zp = (u32x4*)(P->wmix + (size_t)4160 * D_); const u32x4 z0 = {0u, 0u, 0u, 0u};
      for (size_t i = gt; i < (size_t)192 * D_ * 2 / 16; i += gn) zp[i] = z0; }
}

__device__ __forceinline__ void prep_rows(PP P, const int tid) {
    const int wid = tid >> 6, lane = tid & 63;
    for (int row = blockIdx.x * 8 + wid; row < T_; row += gridDim.x * 8) {
        const float* lp = P->lat + (size_t)row * 1024;
#pragma unroll
        for (int part = 0; part < 2; ++part) {
            const f32x4 a0 = *(const f32x4*)(lp + part * 512 + lane * 4), a1 = *(const f32x4*)(lp + part * 512 + 256 + lane * 4);
            float ss = (a0[0] * a0[0] + a0[1] * a0[1]) + (a0[2] * a0[2] + a0[3] * a0[3]) + (a1[0] * a1[0] + a1[1] * a1[1]) + (a1[2] * a1[2] + a1[3] * a1[3]);
            const float r = 1.0f / sqrtf(wave_sum(ss) * (1.0f / 512.0f) + 1e-6f);
            bf16_t* op = (part == 0 ? P->cq : P->ckv) + (size_t)row * 512;
            u32x2 w0, w1; w0.x = cvt_pk_bf16(a0[0] * r, a0[1] * r); w0.y = cvt_pk_bf16(a0[2] * r, a0[3] * r); w1.x = cvt_pk_bf16(a1[0] * r, a1[1] * r); w1.y = cvt_pk_bf16(a1[2] * r, a1[3] * r);
            *(u32x2*)(op + lane * 4) = w0; *(u32x2*)(op + 256 + lane * 4) = w1;
        }
        if (lane < 32) { const float x1 = P->kraw[(size_t)row * 64 + lane], x2 = P->kraw[(size_t)row * 64 + 32 + lane]; const int pos = row & (S_ - 1);
            const float c = P->cosT[pos * 32 + lane], s = P->sinT[pos * 32 + lane];
            P->kpe[(size_t)row * 64 + lane] = (bf16_t)(cvt_pk_bf16(x1 * c - x2 * s, 0.f) & 0xffffu); P->kpe[(size_t)row * 64 + 32 + lane] = (bf16_t)(cvt_pk_bf16(x2 * c + x1 * s, 0.f) & 0xffffu); }
    }
}

__global__ void __launch_bounds__(512, 2) fwd_megakernel(const Params Pk) {
    extern __shared__ __attribute__((aligned(16))) unsigned char lds_raw[];
    LAS unsigned char* lds = (LAS unsigned char*)lds_raw;
    cg::grid_group grid = cg::this_grid();
    const int nphase = ((PP)__builtin_amdgcn_kernarg_segment_ptr())->nphase;
    for (int pi = 0; pi < nphase; ++pi) {
        PP P = (PP)__builtin_amdgcn_kernarg_segment_ptr(); asm volatile("" : "+s"(P));
        int tid = threadIdx.x; asm volatile("" : "+v"(tid));
        const int wid = __builtin_amdgcn_readfirstlane(tid >> 6);
        Phase ph; ph.kind = P->ph[pi].kind; ph.p0 = P->ph[pi].p0; ph.np = P->ph[pi].np; ph.ld = P->ph[pi].ld; ph.arg = P->ph[pi].arg;
        const int kind = ph.kind;
        if ((PHM & 1) && (kind == K_GEMM || kind == K_DUAL)) {
            gemm_phase(lds, P, ph, tid);
        } else if ((PHM & 2) && kind == K_PRO) {
            prologue_misc(P, tid);
            conv_jobs(lds, P, 0, P->njob0, tid);
        } else if ((PHM & 4) && kind == K_LN) {
            const int li = ph.arg;
            const float* g = P->in[li == 0 ? 4 : (li == 1 ? 16 : (li == 2 ? 23 : 27))];
            const float* b = P->in[li == 0 ? 5 : (li == 1 ? 17 : (li == 2 ? 24 : 28))];
            ln_rows(P->z, g, b, P->out, li == 3 ? (bf16_t*)nullptr : P->hb, T_, tid);
            if (li == 0) ln_rows(P->in[1], P->in[18], P->in[19], (float*)nullptr, P->memb, 1024, tid);
            if (li == 1) conv_jobs(lds, P, P->njob0, P->njob1, tid);
        } else if ((PHM & 8) && kind == K_PREPA) {
            prep_rows(P, tid);
            for (int u = blockIdx.x; u < 2048; u += gridDim.x) {
                const int bh = u & 63, cp = u >> 6, b = bh >> 4, h = bh & 15;
                const size_t row0 = (size_t)b * S_ + cp * 128;
                bf16_t* q = P->qka + row0 * 2048 + h * 64;
                const bf16_t* k = P->qka + (size_t)b * S_ * 2048 + 1024 + h * 64;
                const bf16_t* vt = P->vta + (size_t)(h * 64) * T_ + (size_t)b * S_;
                const int cw = cp * 2 + (wid >> 2);
                const int tlo = (cp * 2 - 8) < 0 ? 0 : (cp * 2 - 8), wlo = (cw - 8) < 0 ? 0 : (cw - 8);
                attn_unit<64, 64, 64, 1, true, true>(lds, q, 2048, q, 2048, k, 2048, k, 2048, vt, T_, q, 2048, tlo, cp * 2 + 2, wlo, cw + 1, 0.125f * LOG2E_, cp * 128 + wid * 16, P->in[8] + h * 257, tid);
            }
        } else if ((PHM & 16) && kind == K_MLA) {
            for (int u = blockIdx.x; u < 2048; u += gridDim.x) {
                const int r = u >> 8, c = u & 255, a = c >> 6, bh = c & 63, b = bh >> 4, h = bh & 15;
                const int qi = (r & 1) ? (4 * r + 3 - a) : (4 * r + a);
                const size_t row0 = (size_t)b * S_ + qi * 128;
                bf16_t* q1 = P->hb + row0 * 2048 + h * 128;
                const bf16_t* q2 = P->qr + row0 * 1024 + h * 64;
                const bf16_t* k1 = P->kn + (size_t)b * S_ * 2048 + h * 128;
                const bf16_t* k2 = P->kpe + (size_t)b * S_ * 64;
                const bf16_t* vt = P->vtb + (size_t)(h * 128) * T_ + (size_t)b * S_;
                const int cw = qi * 2 + (wid >> 2);
                attn_unit<192, 128, 128, 1, true, false>(lds, q1, 2048, q2, 1024, k1, 2048, k2, 64, vt, T_, q1, 2048, 0, qi * 2 + 2, 0, cw + 1, 0.07216878364870322f * LOG2E_, 0, (const float*)nullptr, tid);
            }
        } else if ((PHM & 32) && kind == K_XATTN) {
            for (int u = blockIdx.x; u < 2048; u += gridDim.x) {
                const int rbk = u & 31, rest = u >> 5, dvq = rest & 3, h = (rest >> 2) & 3, b = rest >> 4;
                const size_t row0 = (size_t)b * S_ + rbk * 128;
                const bf16_t* q = P->xq + row0 * 2048 + h * 512;
                const bf16_t* k = P->kx + (size_t)(b * 256) * 2048 + h * 512;
                const bf16_t* vt = P->vtx + (size_t)(h * 512 + dvq * 128) * 1024 + b * 256;
                bf16_t* o = P->ox + row0 * 2048 + h * 512 + dvq * 128;
                attn_unit<512, 128, 512, 1, false, false>(lds, q, 2048, q, 2048, k, 2048, k, 2048, vt, 1024, o, 2048, 0, 4, 0, 4, 0.04419417382415922f * LOG2E_, 0, (const float*)nullptr, tid);
            }
        }
        if (pi + 1 < nphase) grid.sync();
    }
}

extern "C" void kernel_launch(void* const* d_in, const int* in_sizes, int n_in, void* d_out, int out_size, void* d_ws, size_t ws_size, hipStream_t stream) {
    static int grid_blocks = 0;
    if (grid_blocks == 0) {
        int dev = 0, cus = 0, per_cu = 0;
        hipGetDevice(&dev);
        hipDeviceGetAttribute(&cus, hipDeviceAttributeMultiprocessorCount, dev);
        if (hipFuncSetAttribute((const void*)fwd_megakernel, hipFuncAttributeMaxDynamicSharedMemorySize, LDS_BYTES) != hipSuccess) fprintf(stderr, "hipFuncSetAttribute failed\n");
        if (hipOccupancyMaxActiveBlocksPerMultiprocessor(&per_cu, (const void*)fwd_megakernel, 512, LDS_BYTES) != hipSuccess || per_cu < 1) { fprintf(stderr, "occupancy query: %d\n", per_cu); per_cu = 1; }
        (void)hipGetLastError();
        grid_blocks = cus * per_cu;
        if (grid_blocks > 256) grid_blocks = 256;
        if (grid_blocks < 1) grid_blocks = 256;
    }
    Params p; memset(&p, 0, sizeof(p));
    for (int i = 0; i < 29; ++i) p.in[i] = (const float*)d_in[i];
    p.out = (float*)d_out; p.ws = (unsigned char*)d_ws;
    unsigned char* ws = (unsigned char*)d_ws;
    size_t o = 0;
    const size_t OFF_WMIX = o; o += (size_t)8448 * 2048 * 2;
    const size_t OFF_WQB = o; o += (size_t)3072 * 512 * 2;
    const size_t OFF_WKVB = o; o += (size_t)4096 * 512 * 2;
    const size_t OFF_WOA = o; o += (size_t)2048 * 2048 * 2;
    const size_t OFF_WOB = o; o += (size_t)2048 * 2048 * 2;
    const size_t OFF_WOUT = o; o += (size_t)2048 * 2048 * 2;
    const size_t OFF_WXQ = o; o += (size_t)2048 * 2048 * 2;
    const size_t OFF_WXO = o; o += (size_t)2048 * 2048 * 2;
    const size_t OFF_WXKV = o; o += (size_t)4096 * 2048 * 2;
    const size_t OFF_RF = o; o += (size_t)11008 * 2048 * 2 + (size_t)2048 * 5504 * 2;
    const size_t OFF_ACT = o; o += (size_t)T_ * DFF_ * 2;
    const size_t OFF_Z = o; o += (size_t)T_ * D_ * 4;
    const size_t OFF_HB = o; o += (size_t)T_ * D_ * 2;
    const size_t OFF_KX = o; o += (size_t)1024 * 2048 * 2;
    const size_t OFF_VTX = o; o += (size_t)2048 * 1024 * 2;
    const size_t OFF_ROPE = o; o += (size_t)S_ * 32 * 4 * 2;
    const size_t OFF_QR = o; o += (size_t)T_ * 1024 * 2;
    const size_t WS_END = o;
    if (ws_size < WS_END) fprintf(stderr, "kernel_launch: workspace too small: need %zu, have %zu\n", WS_END, ws_size);
    bf16_t* wmix = (bf16_t*)(ws + OFF_WMIX); bf16_t* wqb = (bf16_t*)(ws + OFF_WQB); bf16_t* wkvb = (bf16_t*)(ws + OFF_WKVB);
    bf16_t* woa = (bf16_t*)(ws + OFF_WOA); bf16_t* wob = (bf16_t*)(ws + OFF_WOB); bf16_t* wout = (bf16_t*)(ws + OFF_WOUT);
    bf16_t* wxq = (bf16_t*)(ws + OFF_WXQ); bf16_t* wxo = (bf16_t*)(ws + OFF_WXO); bf16_t* wxkv = (bf16_t*)(ws + OFF_WXKV);
    bf16_t* w1t = (bf16_t*)(ws + OFF_RF); bf16_t* w2t = w1t + (size_t)11008 * 2048;
    bf16_t* act = (bf16_t*)(ws + OFF_ACT);
    p.z = (float*)(ws + OFF_Z); p.hb = (bf16_t*)(ws + OFF_HB);
    p.lat = (float*)(ws + OFF_RF); p.vtb = (bf16_t*)(ws + OFF_RF); bf16_t* mixg = (bf16_t*)(ws + OFF_RF);
    p.gates = act;
    p.kraw = (float*)(ws + OFF_ACT + (size_t)134217728);
    p.cq = (bf16_t*)(ws + OFF_ACT + (size_t)138412032);
    p.ckv = (bf16_t*)(ws + OFF_ACT + (size_t)155189248);
    p.kpe = (bf16_t*)(ws + OFF_ACT + (size_t)171966464);
    p.memb = (bf16_t*)(ws + OFF_ACT + (size_t)174063616);
    p.xq = act; p.ox = (bf16_t*)(ws + OFF_ACT + (size_t)67108864);
    p.qka = (bf16_t*)(ws + OFF_Z); p.vta = (bf16_t*)(ws + OFF_Z + (size_t)67108864); p.kn = (bf16_t*)(ws + OFF_Z + (size_t)67108864);
    p.qr = (bf16_t*)(ws + OFF_QR); p.kx = (bf16_t*)(ws + OFF_KX); p.vtx = (bf16_t*)(ws + OFF_VTX);
    p.cosT = (float*)(ws + OFF_ROPE); p.sinT = p.cosT + (size_t)S_ * 32; p.wmix = wmix;
    bf16_t* qn = p.hb;
    float* hf = p.out;
    auto job = [&](int i, int src, bf16_t* dst, const float* ksc, int K, int N, int ldd, int mode) {
        p.job[i].W = p.in[src]; p.job[i].dst = dst; p.job[i].ksc = ksc; p.job[i].K = K; p.job[i].N = N; p.job[i].ldd = ldd; p.job[i].mode = mode; p.job[i].ntiles = (K / 64) * (N / 64); };
    job(0, 2, w1t, nullptr, 2048, 11008, 2048, 1);
    job(1, 3, w2t, nullptr, 5504, 2048, 5504, 0);
    job(2, 6, wmix, nullptr, 2048, 8256, 2048, 2);
    job(3, 10, wqb, p.in[9], 512, 3072, 512, 3);
    job(4, 12, wkvb, p.in[11], 512, 4096, 512, 4);
    job(5, 13, woa, nullptr, 1024, 2048, 2048, 0);
    job(6, 14, wob, nullptr, 2048, 2048, 2048, 0);
    job(7, 15, wout, nullptr, 2048, 2048, 2048, 0);
    job(8, 20, wxq, nullptr, 2048, 2048, 2048, 0);
    job(9, 21, wxkv, nullptr, 2048, 4096, 2048, 0);
    job(10, 22, wxo, nullptr, 2048, 2048, 2048, 0);
    job(11, 25, w1t, nullptr, 2048, 11008, 2048, 1);
    job(12, 26, w2t, nullptr, 5504, 2048, 5504, 0);
    p.njob0 = 11; p.njob1 = 13;
    int np = 0, nph = 0;
    auto prob = [&](const bf16_t* A, const bf16_t* B, void* out, const void* aux, const void* aux2, int nM, int nN, int K, int epi, int ldo, float f0, float f1) {
        Prob& q = p.pr[np]; q.A = A; q.B = B; q.out = out; q.aux = aux; q.aux2 = aux2; q.nM = nM; q.nN = nN; q.nt = K / 64; q.epi = epi; q.ldo = ldo; q.f0 = f0; q.f1 = f1; return np++; };
    auto phase = [&](int kind, int p0, int npr, int ld, int arg) { Phase& h = p.ph[nph++]; h.kind = kind; h.p0 = p0; h.np = npr; h.ld = ld; h.arg = arg; };
    phase(K_PRO, 0, 0, 0, 0);
    { int a = prob(p.hb, w1t, act, nullptr, nullptr, 64, 43, 2048, E_SWIGLU, DFF_, 0.f, 0.f); phase(K_GEMM, a, 1, 2048, 0); }
    { int a = prob(act, w2t, p.z, p.in[0], nullptr, 64, 8, DFF_, E_RESZ, D_, ALPHA_, 0.5f); phase(K_GEMM, a, 1, DFF_, 0); }
    phase(K_LN, 0, 0, 0, 0);
    { int a = prob(p.hb, wmix, p.qka, nullptr, nullptr, 64, 8, 2048, E_BF16, 2048, 0.f, 0.f);
      prob(wmix + (size_t)2048 * 2048, p.hb, p.vta, nullptr, nullptr, 4, 64, 2048, E_BF16, T_, 0.f, 0.f);
      prob(p.hb, wmix + (size_t)3072 * 2048, p.lat, nullptr, p.kraw, 64, 5, 2048, E_LAT, 1024, 0.f, 0.f);
      prob(p.hb, wmix + (size_t)4352 * 2048, p.gates, p.in[7], nullptr, 64, 16, 2048, E_GATES, 4096, 0.f, 0.f);
      prob(p.memb, wxkv, p.kx, nullptr, nullptr, 4, 8, 2048, E_BF16, 2048, 0.f, 0.f);
      prob(wxkv + (size_t)2048 * 2048, p.memb, p.vtx, nullptr, nullptr, 8, 4, 2048, E_BF16, 1024, 0.f, 0.f);
      phase(K_GEMM, a, 6, 2048, 0); }
    phase(K_PREPA, 0, 0, 0, 0);
    { int a = prob(p.cq, wqb, qn, nullptr, nullptr, 64, 8, 512, E_BF16, 2048, 0.f, 0.f);
      prob(p.cq, wqb + (size_t)2048 * 512, p.qr, p.cosT, p.sinT, 64, 4, 512, E_ROPEQ, 1024, 0.f, 0.f);
      prob(p.ckv, wkvb, p.kn, nullptr, nullptr, 64, 8, 512, E_BF16, 2048, 0.f, 0.f);
      prob(wkvb + (size_t)2048 * 512, p.ckv, p.vtb, nullptr, nullptr, 8, 64, 512, E_BF16, T_, 0.f, 0.f);
      phase(K_GEMM, a, 4, 512, 0); }
    phase(K_MLA, 0, 0, 0, 0);
    { bf16_t* tga = (bf16_t*)(ws + OFF_Z + (size_t)67108864);
      int a = prob(p.qka, woa, tga, p.gates, nullptr, 64, 8, 1024, E_DUAL0, 2048, 0.f, 0.f);
      prob(qn, wob, mixg, p.gates, tga, 64, 8, 2048, E_DUAL1, 2048, 0.f, 0.f);
      phase(K_DUAL, a, 2, 2048, 0); }
    { int a = prob(mixg, wout, p.z, hf, nullptr, 64, 8, 2048, E_RESZ, D_, ALPHA_, 1.0f); phase(K_GEMM, a, 1, 2048, 0); }
    phase(K_LN, 0, 0, 0, 1);
    { int a = prob(p.hb, wxq, p.xq, nullptr, nullptr, 64, 8, 2048, E_BF16, 2048, 0.f, 0.f); phase(K_GEMM, a, 1, 2048, 0); }
    phase(K_XATTN, 0, 0, 0, 0);
    { int a = prob(p.ox, wxo, p.z, hf, nullptr, 64, 8, 2048, E_RESZ, D_, ALPHA_, 1.0f); phase(K_GEMM, a, 1, 2048, 0); }
    phase(K_LN, 0, 0, 0, 2);
    { int a = prob(p.hb, w1t, act, nullptr, nullptr, 64, 43, 2048, E_SWIGLU, DFF_, 0.f, 0.f); phase(K_GEMM, a, 1, 2048, 0); }
    { int a = prob(act, w2t, p.z, hf, nullptr, 64, 8, DFF_, E_RESZ, D_, ALPHA_, 0.5f); phase(K_GEMM, a, 1, DFF_, 0); }
    phase(K_LN, 0, 0, 0, 3);
    p.nphase = nph;
    void* args[] = {(void*)&p};
    hipError_t e = hipLaunchCooperativeKernel((const void*)fwd_megakernel, dim3(grid_blocks), dim3(512), args, LDS_BYTES, stream);
    if (e != hipSuccess) fprintf(stderr, "cooperative launch failed: %s (grid %d)\n", hipGetErrorString(e), grid_blocks);
}
```

```cpp
#include <hip/hip_runtime.h>
#include <hip/hip_cooperative_groups.h>
#include <cstdio>
#include <cstdint>
#include <cstring>
namespace cg = cooperative_groups;

#define LAS __attribute__((address_space(3)))
typedef unsigned short bf16_t;
typedef short bf16x8 __attribute__((ext_vector_type(8)));
typedef float f32x4 __attribute__((ext_vector_type(4)));
typedef float f32x2 __attribute__((ext_vector_type(2)));
typedef unsigned u32x4 __attribute__((ext_vector_type(4)));
typedef unsigned u32x2 __attribute__((ext_vector_type(2)));

constexpr int T_ = 16384, D_ = 2048, S_ = 4096, DFF_ = 5504;
constexpr float ALPHA_ = 1.1892071150027210667f;
constexpr float LOG2E_ = 1.4426950408889634f;
constexpr int LDS_BYTES = 147456;
#ifndef EPIMASK
#define EPIMASK 511
#endif
#define EPIM(e) ((EPIMASK >> (e)) & 1)
#ifndef PROBE_MASK
#define PROBE_MASK 0
#endif
#ifndef PHM
#define PHM 63
#endif

enum { E_BF16 = 0, E_LAT, E_GATES, E_SWIGLU, E_RESZ, E_ROPEQ, E_DUAL0, E_DUAL1, E_SOFTMAX };
enum { K_PRO = 0, K_GEMM, K_DUAL, K_LN, K_PREPA, K_MLA, K_XATTN };

struct Prob {
    const bf16_t* A; const bf16_t* B; void* out; const void* aux; const void* aux2;
    int nM, nN, nt, epi, ldo; float f0, f1; int bmode;
};
struct Phase { int kind, p0, np, ld, arg, pad0, pad1, pad2; };
struct CJob { const float* W; bf16_t* dst; const float* ksc; int K, N, ldd, mode, ntiles, pad; };
struct Params {
    const float* in[29];
    float* out;
    unsigned char* ws;
    float* z; bf16_t* hb; float* lat; float* kraw; bf16_t* cq; bf16_t* ckv; bf16_t* kpe; bf16_t* memb;
    bf16_t* qka; bf16_t* vta; bf16_t* kn; bf16_t* qr; bf16_t* vtb; bf16_t* gates; bf16_t* xq; bf16_t* ox; bf16_t* kx; bf16_t* vtx;
    float* cosT; float* sinT; bf16_t* wmix; unsigned* bar; float* stats;
    int nphase, njob0, njob1, pad;
    Phase ph[24];
    Prob pr[28];
    CJob job[13];
};

static_assert(sizeof(Params) <= 4000, "kernel argument too large");
typedef const Params __attribute__((address_space(4)))* PP;

typedef __bf16 bf2_t __attribute__((ext_vector_type(2)));
__device__ __forceinline__ unsigned cvt_pk_bf16(float lo, float hi) { const f32x2 f = {lo, hi}; const bf2_t r = __builtin_convertvector(f, bf2_t); return __builtin_bit_cast(unsigned, r); }
__device__ __forceinline__ float bf_lo(unsigned w) { return __uint_as_float(w << 16); }
__device__ __forceinline__ float bf_hi(unsigned w) { return __uint_as_float(w & 0xffff0000u); }
__device__ __forceinline__ float wave_sum(float v) {
#pragma unroll
    for (int o = 1; o < 64; o <<= 1) v += __shfl_xor(v, o);
    return v;
}
__device__ __forceinline__ float fast_exp2(float x) { return __builtin_amdgcn_exp2f(x); }
__device__ __forceinline__ float sigmoidf_(float x) { return __builtin_amdgcn_rcpf(1.0f + fast_exp2(-x * LOG2E_)); }

constexpr int BM = 256, BK = 64, HALF = 128, HTB = HALF * BK * 2;
__host__ __device__ __forceinline__ int lds_byte(int r, int c) { const int st = (r >> 4) * 2 + (c >> 5), rr = r & 15, cc = c & 31, ob = rr * 64 + cc * 2; return st * 1024 + (ob ^ (((ob >> 9) & 1) << 5)); }
__host__ __device__ __forceinline__ void stage_rc(int b, int& R, int& C) { const int st = b / 1024, sb = b % 1024, swz = sb ^ (((sb >> 9) & 1) << 5); R = (st >> 1) * 16 + swz / 64; C = (st & 1) * 32 + (swz % 64) / 2; }

struct GU { const char* A; const char* B; int nt, pm, pn, pi; };
__device__ __forceinline__ const char* uni_ptr(const char* p) { const unsigned long long v = (unsigned long long)p; const unsigned lo = __builtin_amdgcn_readfirstlane((unsigned)v), hi = __builtin_amdgcn_readfirstlane((unsigned)(v >> 32)); return (const char*)(((unsigned long long)hi << 32) | lo); }

__device__ __forceinline__ bool g_next(PP P, const Phase& ph, int i, GU& u) {
    const int G = gridDim.x, c = blockIdx.x;
    const bool dual = ph.kind == K_DUAL;
    const int ti = dual ? (i >> 1) : i;
    long L = (long)ti * G + c;
    int pi = ph.p0; bool found = false;
    const int np = dual ? 1 : ph.np;
    for (int k = 0; k < np; ++k) { const int cnt = P->pr[pi].nM * P->pr[pi].nN; if (L < cnt) { found = true; break; } L -= cnt; ++pi; }
    if (!__builtin_amdgcn_readfirstlane((int)found)) return false;
    L = __builtin_amdgcn_readfirstlane((int)L); pi = __builtin_amdgcn_readfirstlane(pi);
    const int nM = P->pr[pi].nM, nN = P->pr[pi].nN, nwg = nM * nN;
    int wgid = (int)L; { const int q = nwg / 8, r = nwg % 8, xcd = wgid % 8, off = wgid / 8; wgid = (xcd < r ? xcd * (q + 1) : r * (q + 1) + (xcd - r) * q) + off; }
    const int nig = 8 * nN, gid = wgid / nig, fm = gid * 8, gsz = (nM - fm) < 8 ? (nM - fm) : 8;
    u.pm = __builtin_amdgcn_readfirstlane(fm + ((wgid % nig) % gsz)); u.pn = __builtin_amdgcn_readfirstlane((wgid % nig) / gsz);
    if (dual) pi += (i & 1);
    pi = __builtin_amdgcn_readfirstlane(pi);
    u.pi = pi;
    const size_t tstep = (size_t)BM * ph.ld * 2;
    u.A = uni_ptr((const char*)P->pr[pi].A + (size_t)u.pm * tstep); { const int bm = P->pr[pi].bmode; const size_t boffs = bm == 1 ? (size_t)(u.pm >> 4) * tstep : (bm == 2 ? (size_t)u.pn * tstep + (size_t)(u.pm >> 4) * 512 : (size_t)u.pn * tstep); u.B = uni_ptr((const char*)P->pr[pi].B + boffs); } u.nt = __builtin_amdgcn_readfirstlane(P->pr[pi].nt);
    return true;
}

__device__ __forceinline__ u32x4 pack8(const f32x4 a, const f32x4 b) { u32x4 w; w.x = cvt_pk_bf16(a[0], a[1]); w.y = cvt_pk_bf16(a[2], a[3]); w.z = cvt_pk_bf16(b[0], b[1]); w.w = cvt_pk_bf16(b[2], b[3]); return w; }
__device__ __forceinline__ void unpack8(const u32x4 w, f32x4& a, f32x4& b) { a = (f32x4){bf_lo(w.x), bf_hi(w.x), bf_lo(w.y), bf_hi(w.y)}; b = (f32x4){bf_lo(w.z), bf_hi(w.z), bf_lo(w.w), bf_hi(w.w)}; }
__device__ __forceinline__ void g_epi(PP P, const GU& u, f32x4 (&acc)[2][2][4][2], int wr, int wc, int fr, int fq, LAS unsigned char* lds) {
#define pr (P->pr[u.pi])
#ifdef EPIFORCE
    const int epi = EPIFORCE;
#else
    const int epi = pr.epi;
#endif
    const int rowb = u.pm * BM + wr * 64 + fr;
    const int colb = u.pn * BM + wc * 32 + fq * 8;
    if (epi == E_BF16) {
        bf16_t* O = (bf16_t*)pr.out; const int ldo = pr.ldo;
#pragma unroll
        for (int ai = 0; ai < 2; ++ai)
#pragma unroll
            for (int m = 0; m < 4; ++m) { asm volatile("" ::: "memory"); bf16_t* rp = O + (size_t)(rowb + ai * HALF + m * 16) * ldo + colb;
#pragma unroll
                for (int bj = 0; bj < 2; ++bj) *(u32x4*)(rp + bj * HALF) = pack8(acc[ai][bj][m][0], acc[ai][bj][m][1]); }
    } else if (EPIM(E_LAT) && epi == E_LAT) {
        if (u.pn < 4) {
            float* O = (float*)pr.out;
#pragma unroll
            for (int ai = 0; ai < 2; ++ai)
#pragma unroll
                for (int m = 0; m < 4; ++m) { asm volatile("" ::: "memory"); float* rp = O + (size_t)(rowb + ai * HALF + m * 16) * 1024 + colb;
#pragma unroll
                    for (int bj = 0; bj < 2; ++bj)
#pragma unroll
                        for (int n = 0; n < 2; ++n) *(f32x4*)(rp + bj * HALF + n * 4) = acc[ai][bj][m][n]; }
        } else if (wc < 2) {
            float* O = (float*)pr.aux2;
#pragma unroll
            for (int ai = 0; ai < 2; ++ai)
#pragma unroll
                for (int m = 0; m < 4; ++m) { asm volatile("" ::: "memory"); float* rp = O + (size_t)(rowb + ai * HALF + m * 16) * 64 + wc * 32 + fq * 8;
#pragma unroll
                    for (int n = 0; n < 2; ++n) *(f32x4*)(rp + n * 4) = acc[ai][0][m][n]; }
        }
    } else if (EPIM(E_GATES) && epi == E_GATES) {
        bf16_t* O = (bf16_t*)pr.out; const float* bias = (const float*)pr.aux;
#pragma unroll
        for (int bj = 0; bj < 2; ++bj) { const f32x4 b0 = *(const f32x4*)(bias + colb + bj * HALF), b1 = *(const f32x4*)(bias + colb + bj * HALF + 4);
#pragma unroll
            for (int ai = 0; ai < 2; ++ai)
#pragma unroll
                for (int m = 0; m < 4; ++m) { asm volatile("" ::: "memory"); f32x4 v0 = acc[ai][bj][m][0] + b0, v1 = acc[ai][bj][m][1] + b1;
#pragma unroll
                    for (int j = 0; j < 4; ++j) { v0[j] = sigmoidf_(v0[j]); v1[j] = sigmoidf_(v1[j]); }
                    *(u32x4*)(O + (size_t)(rowb + ai * HALF + m * 16) * 4096 + colb + bj * HALF) = pack8(v0, v1); } }
    } else if (EPIM(E_SWIGLU) && epi == E_SWIGLU) {
        bf16_t* O = (bf16_t*)pr.out; const int cb = u.pn * 128 + wc * 32 + fq * 8;
#pragma unroll
        for (int ai = 0; ai < 2; ++ai)
#pragma unroll
            for (int m = 0; m < 4; ++m) { asm volatile("" ::: "memory"); f32x4 v[2];
#pragma unroll
                for (int n = 0; n < 2; ++n) { const f32x4 g = acc[ai][0][m][n], uu = acc[ai][1][m][n];
#pragma unroll
                    for (int j = 0; j < 4; ++j) v[n][j] = g[j] * sigmoidf_(g[j]) * uu[j]; }
                *(u32x4*)(O + (size_t)(rowb + ai * HALF + m * 16) * DFF_ + cb) = pack8(v[0], v[1]); }
    } else if (EPIM(E_RESZ) && epi == E_RESZ) {
        float* O = (float*)pr.out; const float f0 = pr.f0, f1 = pr.f1; const int lp = pr.ldo;
        const int colb = u.pn * BM + wc * 32 + fq * 4;
        if (lp < 0) {
            const float* R = (const float*)pr.aux;
#pragma unroll
            for (int ai = 0; ai < 2; ++ai)
#pragma unroll
                for (int m = 0; m < 4; ++m) { asm volatile("" ::: "memory"); const size_t off = (size_t)(rowb + ai * HALF + m * 16) * D_ + colb;
#pragma unroll
                    for (int bj = 0; bj < 2; ++bj)
#pragma unroll
                        for (int n = 0; n < 2; ++n) { const f32x4 r = *(const f32x4*)(R + off + bj * HALF + n * 16); *(f32x4*)(O + off + bj * HALF + n * 16) = r * f0 + acc[ai][bj][m][n] * f1; } }
        } else {
            const float* st = (const float*)pr.aux2;
            const float* g = P->in[lp == 0 ? 4 : (lp == 1 ? 16 : 23)] + colb;
            const float* b = P->in[lp == 0 ? 5 : (lp == 1 ? 17 : 24)] + colb;
            f32x2 ms[2][4];
#pragma unroll
            for (int ai = 0; ai < 2; ++ai)
#pragma unroll
                for (int m = 0; m < 4; ++m) ms[ai][m] = *(const f32x2*)(st + (size_t)(rowb + ai * HALF + m * 16) * 2);
#pragma unroll
            for (int bj = 0; bj < 2; ++bj)
#pragma unroll
                for (int n = 0; n < 2; ++n) { asm volatile("" ::: "memory"); const f32x4 gv = *(const f32x4*)(g + bj * HALF + n * 16), bv = *(const f32x4*)(b + bj * HALF + n * 16);
#pragma unroll
                    for (int ai = 0; ai < 2; ++ai)
#pragma unroll
                        for (int m = 0; m < 4; ++m) { const size_t off = (size_t)(rowb + ai * HALF + m * 16) * D_ + colb + bj * HALF + n * 16; const f32x4 zo = *(const f32x4*)(O + off);
                            const f32x4 h = (zo - ms[ai][m].x) * ms[ai][m].y * gv + bv; *(f32x4*)(O + off) = h * f0 + acc[ai][bj][m][n] * f1; } }
        }
    } else if (EPIM(E_ROPEQ) && epi == E_ROPEQ) {
        bf16_t* O = (bf16_t*)pr.out; const float* cT = (const float*)pr.aux; const float* sT = (const float*)pr.aux2;
        const int head = u.pn * 4 + wc, ri = fq * 8;
#pragma unroll
        for (int ai = 0; ai < 2; ++ai)
#pragma unroll
            for (int m = 0; m < 4; ++m) { asm volatile("" ::: "memory"); const int row = rowb + ai * HALF + m * 16; const int pos = row & (S_ - 1);
                f32x4 o1[2], o2[2];
#pragma unroll
                for (int n = 0; n < 2; ++n) { const f32x4 cs = *(const f32x4*)(cT + pos * 32 + ri + n * 4), sn = *(const f32x4*)(sT + pos * 32 + ri + n * 4);
                    const f32x4 x1 = acc[ai][0][m][n], x2 = acc[ai][1][m][n]; o1[n] = x1 * cs - x2 * sn; o2[n] = x2 * cs + x1 * sn; }
                bf16_t* rp = O + (size_t)row * 1024 + head * 64 + ri; *(u32x4*)rp = pack8(o1[0], o1[1]); *(u32x4*)(rp + 32) = pack8(o2[0], o2[1]); }
    } else if (EPIM(E_SOFTMAX) && epi == E_SOFTMAX) {
        bf16_t* O = (bf16_t*)pr.out; const int ldo = pr.ldo; const float sc = pr.f0;
        int rb_ = wr * 64 + fr; asm volatile("" : "+v"(rb_));
        LAS float* xr = (LAS float*)(lds + 131072) + rb_;
        LAS float* xw = xr + wc * 256;
#pragma unroll
        for (int ai = 0; ai < 2; ++ai)
#pragma unroll
            for (int m = 0; m < 4; ++m) { asm volatile("" ::: "memory"); float mx = -3e38f;
#pragma unroll
                for (int bj = 0; bj < 2; ++bj)
#pragma unroll
                    for (int n = 0; n < 2; ++n) { const f32x4 v = acc[ai][bj][m][n]; mx = fmaxf(fmaxf(mx, fmaxf(v[0], v[1])), fmaxf(v[2], v[3])); }
                mx = fmaxf(mx, __shfl_xor(mx, 16)); mx = fmaxf(mx, __shfl_xor(mx, 32));
                if (fq == 0) xw[ai * HALF + m * 16] = mx; }
        asm volatile("s_waitcnt lgkmcnt(0)" ::: "memory"); __builtin_amdgcn_s_barrier(); asm volatile("" ::: "memory");
#pragma unroll
        for (int ai = 0; ai < 2; ++ai)
#pragma unroll
            for (int m = 0; m < 4; ++m) { asm volatile("" ::: "memory"); const int ro = ai * HALF + m * 16; const float mx = fmaxf(fmaxf(xr[ro], xr[256 + ro]), fmaxf(xr[512 + ro], xr[768 + ro])) * sc; float ps = 0.f;
#pragma unroll
                for (int bj = 0; bj < 2; ++bj)
#pragma unroll
                    for (int n = 0; n < 2; ++n) { const f32x4 v = acc[ai][bj][m][n];
#pragma unroll
                        for (int j = 0; j < 4; ++j) ps += fast_exp2(__builtin_fmaf(v[j], sc, -mx)); }
                ps += __shfl_xor(ps, 16); ps += __shfl_xor(ps, 32);
                if (fq == 0) xw[1024 + ro] = ps; }
        asm volatile("s_waitcnt lgkmcnt(0)" ::: "memory"); __builtin_amdgcn_s_barrier(); asm volatile("" ::: "memory");
#pragma unroll
        for (int ai = 0; ai < 2; ++ai)
#pragma unroll
            for (int m = 0; m < 4; ++m) { asm volatile("" ::: "memory"); const int ro = ai * HALF + m * 16; const float inv = __builtin_amdgcn_rcpf((xr[1024 + ro] + xr[1280 + ro]) + (xr[1536 + ro] + xr[1792 + ro]));
                const float mx = fmaxf(fmaxf(xr[ro], xr[256 + ro]), fmaxf(xr[512 + ro], xr[768 + ro])) * sc;
                bf16_t* rp = O + (size_t)(rowb + ai * HALF + m * 16) * ldo + colb;
#pragma unroll
                for (int bj = 0; bj < 2; ++bj) { f32x4 v[2];
#pragma unroll
                    for (int n = 0; n < 2; ++n) { const f32x4 a = acc[ai][bj][m][n];
#pragma unroll
                        for (int j = 0; j < 4; ++j) v[n][j] = fast_exp2(__builtin_fmaf(a[j], sc, -mx)) * inv; }
                    *(u32x4*)(rp + bj * HALF) = pack8(v[0], v[1]); } }
    } else if (EPIM(E_DUAL0) && epi == E_DUAL0) {
        const bf16_t* G = (const bf16_t*)pr.aux; bf16_t* O = (bf16_t*)pr.out;
#pragma unroll
        for (int ai = 0; ai < 2; ++ai)
#pragma unroll
            for (int m = 0; m < 4; ++m) { asm volatile("" ::: "memory"); const size_t ro = (size_t)(rowb + ai * HALF + m * 16);
#pragma unroll
                for (int bj = 0; bj < 2; ++bj) { f32x4 g0, g1; unpack8(*(const u32x4*)(G + ro * 4096 + colb + bj * HALF), g0, g1);
                    *(u32x4*)(O + ro * D_ + colb + bj * HALF) = pack8(acc[ai][bj][m][0] * g0, acc[ai][bj][m][1] * g1); } }
    } else if (EPIM(E_DUAL1) && epi == E_DUAL1) {
        const bf16_t* G = (const bf16_t*)pr.aux; bf16_t* O = (bf16_t*)pr.out; const bf16_t* Tm = (const bf16_t*)pr.aux2;
#pragma unroll
        for (int ai = 0; ai < 2; ++ai)
#pragma unroll
            for (int m = 0; m < 4; ++m) { asm volatile("" ::: "memory"); const size_t ro = (size_t)(rowb + ai * HALF + m * 16);
#pragma unroll
                for (int bj = 0; bj < 2; ++bj) { f32x4 g0, g1, t0, t1; unpack8(*(const u32x4*)(G + ro * 4096 + 2048 + colb + bj * HALF), g0, g1); unpack8(*(const u32x4*)(Tm + ro * D_ + colb + bj * HALF), t0, t1);
                    *(u32x4*)(O + ro * D_ + colb + bj * HALF) = pack8(t0 + acc[ai][bj][m][0] * g0, t1 + acc[ai][bj][m][1] * g1); } }
    }
}
#undef pr
__device__ __forceinline__ void gemm_phase(LAS unsigned char* lds, PP P, const Phase& ph, const int tid) {
    const int wid = __builtin_amdgcn_readfirstlane(tid >> 6), lane = tid & 63, wr = wid >> 2, wc = wid & 3, fr = lane & 15, fq = lane >> 4;
    const int ld = ph.ld;
    const bool perm = P->pr[ph.p0].epi != E_RESZ;
    unsigned voff[2], voffB[2];
#pragma unroll
    for (int i = 0; i < 2; ++i) { int R, C; stage_rc(tid * 16 + i * 8192, R, C); const int rho = R & 31, Rb = (R & ~31) + (8 * ((rho & 15) >> 2) + 4 * (rho >> 4) + (rho & 3));
        voff[i] = (unsigned)(R * ld + C) * 2u; voffB[i] = (unsigned)((perm ? Rb : R) * ld + C) * 2u; }
    const size_t kstep = (size_t)(BK * 2);
    const size_t hstep = (size_t)HALF * ld * 2;
    const unsigned ldsw = (unsigned)wid * 1024u;
    const int aoff = lds_byte(wr * 64 + fr, fq * 8), boff = lds_byte(wc * 32 + fr, fq * 8);
#define PG8_SA(b, h) (((b) * 2 + (h)) * HTB)
#define PG8_SB(b, h) ((4 + (b) * 2 + (h)) * HTB)
#define PG8_STAGE(bufoff, gbase) do { _Pragma("unroll") for (int _i = 0; _i < 2; ++_i) \
        __builtin_amdgcn_global_load_lds((const unsigned*)((const char*)(gbase) + (((bufoff) >= 4 * HTB) ? voffB[_i] : voff[_i])), (LAS unsigned*)(lds + (bufoff) + ldsw + _i * 8192), 16, 0, 0); } while (0)
#define PG8_LDA(dst, b, h) do { _Pragma("unroll") for (int m = 0; m < 4; ++m) _Pragma("unroll") for (int k = 0; k < 2; ++k) dst[m][k] = *(const LAS bf16x8*)(lds + PG8_SA(b, h) + aoff + m * 2048 + k * 1024); } while (0)
#define PG8_LDB(dst, b, h) do { _Pragma("unroll") for (int n = 0; n < 2; ++n) _Pragma("unroll") for (int k = 0; k < 2; ++k) dst[n][k] = *(const LAS bf16x8*)(lds + PG8_SB(b, h) + boff + n * 2048 + k * 1024); } while (0)
#define PG8_MMA(ai, bj, At, Bt) do { __builtin_amdgcn_s_setprio(1); _Pragma("unroll") for (int m = 0; m < 4; ++m) _Pragma("unroll") for (int n = 0; n < 2; ++n) _Pragma("unroll") for (int k = 0; k < 2; ++k) \
        acc[ai][bj][m][n] = __builtin_amdgcn_mfma_f32_16x16x32_bf16(Bt[n][k], At[m][k], acc[ai][bj][m][n], 0, 0, 0); __builtin_amdgcn_s_setprio(0); } while (0)
#define PG8_WAIT_V(n) asm volatile("s_waitcnt vmcnt(" #n ")" ::: "memory")
#define PG8_WAIT_L(n) asm volatile("s_waitcnt lgkmcnt(" #n ")" ::: "memory")
#define PG8_BAR __builtin_amdgcn_s_barrier()
#define PG8_SCHED __builtin_amdgcn_sched_barrier(0)
    GU cur, nxt; int ui = 0;
    if (!g_next(P, ph, 0, cur)) return;
    f32x4 acc[2][2][4][2];
#pragma unroll
    for (int a = 0; a < 2; ++a)
#pragma unroll
        for (int b = 0; b < 2; ++b)
#pragma unroll
            for (int m = 0; m < 4; ++m)
#pragma unroll
                for (int n = 0; n < 2; ++n) acc[a][b][m][n] = (f32x4){0.f, 0.f, 0.f, 0.f};
    bf16x8 At[4][2], B0[2][2], B1[2][2];
    const char* cA = cur.A; const char* cB = cur.B;
    PG8_STAGE(PG8_SB(0, 0), cB); PG8_STAGE(PG8_SB(0, 1), cB + hstep); PG8_STAGE(PG8_SA(0, 0), cA); PG8_STAGE(PG8_SA(0, 1), cA + hstep);
    if (wr == 1) PG8_BAR;
    PG8_WAIT_V(2); PG8_BAR;
    PG8_STAGE(PG8_SB(1, 0), cB + kstep); PG8_STAGE(PG8_SA(1, 0), cA + kstep); PG8_STAGE(PG8_SB(1, 1), cB + hstep + kstep);
    PG8_WAIT_V(6); PG8_BAR;
    for (;;) {
        const bool has_next = g_next(P, ph, ui + 1, nxt);
        const char* nA = has_next ? nxt.A : cA; const char* nB = has_next ? nxt.B : cB;
        const int nt = cur.nt;
        for (int t = 0; t < nt; t += 2) {
            const bool last = (t == nt - 2);
            const char* a1 = cA + (size_t)(t + 1) * kstep;
            const char* a2 = last ? nA : cA + (size_t)(t + 2) * kstep; const char* b2 = last ? nB : cB + (size_t)(t + 2) * kstep;
            const char* a3 = a2 + kstep; const char* b3 = b2 + kstep;
            PG8_LDB(B0, 0, 0); PG8_LDB(B1, 0, 1); PG8_SCHED; PG8_LDA(At, 0, 0); PG8_STAGE(PG8_SA(1, 1), a1 + hstep);
            PG8_WAIT_V(8); PG8_WAIT_L(0); PG8_BAR; PG8_MMA(0, 0, At, B0); PG8_MMA(0, 1, At, B1); PG8_BAR; PG8_SCHED;
            PG8_LDA(At, 0, 1); PG8_STAGE(PG8_SB(0, 0), b2); PG8_STAGE(PG8_SB(0, 1), b2 + hstep); PG8_STAGE(PG8_SA(0, 0), a2);
            PG8_WAIT_V(8); PG8_WAIT_L(0); PG8_BAR; PG8_MMA(1, 0, At, B0); PG8_MMA(1, 1, At, B1); PG8_BAR; PG8_SCHED;
            PG8_LDB(B0, 1, 0); PG8_LDB(B1, 1, 1); PG8_SCHED; PG8_LDA(At, 1, 0); PG8_STAGE(PG8_SA(0, 1), a2 + hstep);
            PG8_WAIT_V(8); PG8_WAIT_L(0); PG8_BAR; PG8_MMA(0, 0, At, B0); PG8_MMA(0, 1, At, B1); PG8_BAR; PG8_SCHED;
            PG8_LDA(At, 1, 1); PG8_STAGE(PG8_SB(1, 0), b3); PG8_STAGE(PG8_SB(1, 1), b3 + hstep); PG8_STAGE(PG8_SA(1, 0), a3);
            PG8_WAIT_V(8); PG8_WAIT_L(0); PG8_BAR; PG8_MMA(1, 0, At, B0); PG8_MMA(1, 1, At, B1); PG8_BAR; PG8_SCHED;
        }
        if (wr == 0) PG8_BAR;
        g_epi(P, cur, acc, wr, wc, fr, fq, lds);
        if (!has_next) break;
#pragma unroll
        for (int a = 0; a < 2; ++a)
#pragma unroll
            for (int b = 0; b < 2; ++b)
#pragma unroll
                for (int m = 0; m < 4; ++m)
#pragma unroll
                    for (int n = 0; n < 2; ++n) acc[a][b][m][n] = (f32x4){0.f, 0.f, 0.f, 0.f};
        cur = nxt; cA = nA; cB = nB; ++ui;
        if (wr == 1) PG8_BAR;
    }
    PG8_WAIT_V(0);
    PG8_BAR;
#undef PG8_SA
#undef PG8_SB
#undef PG8_STAGE
#undef PG8_LDA
#undef PG8_LDB
#undef PG8_MMA
}

template <int DQK, int DV, int W1, int QB, bool PF, bool BIAS>
__device__ __forceinline__ void attn_unit_reg(LAS unsigned char* lds, const bf16_t* Q1, int ldq1, const bf16_t* Q2, int ldq2,
                                          const bf16_t* K1, int ldk1, const bf16_t* K2, int ldk2, const bf16_t* Vt, int ldv, bf16_t* O, int ldo,
                                          int tlo, int thi, int wlo, int whi, float scale2, int qpos_w, const float* rbias, const int tid) {
    constexpr int KS = DQK * 2 + 16, KBYTES = 64 * KS, VS = 144, VBYTES = DV * VS, NBUF = PF ? 2 : 1;
    constexpr int KC = DQK / 64, VC = DV / 64, NKS = DQK / 32, NDB = DV / 16, CPR = DQK / 8;
    const int wid = __builtin_amdgcn_readfirstlane(tid >> 6), lane = tid & 63, fr = lane & 15, fq = lane >> 4;
    LAS unsigned char* kbase = lds;
    LAS unsigned char* vbase = lds + NBUF * KBYTES;
    LAS float* rb = (LAS float*)(lds + NBUF * (KBYTES + VBYTES));
    if (BIAS) { if (tid < 257) rb[tid] = rbias[tid] * LOG2E_; }
    bf16x8 qf[QB][NKS];
#pragma unroll
    for (int qb = 0; qb < QB; ++qb) { const int row = wid * 16 * QB + qb * 16 + fr;
#pragma unroll
        for (int ks = 0; ks < NKS; ++ks) { const int col = ks * 32 + fq * 8;
            qf[qb][ks] = (col < W1) ? *(const bf16x8*)(Q1 + (size_t)row * ldq1 + col) : *(const bf16x8*)(Q2 + (size_t)row * ldq2 + (col - W1)); } }
    f32x4 oacc[QB][NDB];
    float mrun[QB], lrun[QB];
#pragma unroll
    for (int qb = 0; qb < QB; ++qb) { mrun[qb] = -1e30f; lrun[qb] = 0.f;
#pragma unroll
        for (int db = 0; db < NDB; ++db) oacc[qb][db] = (f32x4){0.f, 0.f, 0.f, 0.f}; }
    bf16x8 kreg[KC], vreg[VC];
#define ATT_LOADK(kt) do { \
        _Pragma("unroll") for (int i = 0; i < KC; ++i) { const int ci = tid + 512 * i, row = ci / CPR, col = (ci % CPR) * 8; const size_t key = (size_t)(kt) * 64 + row; \
            kreg[i] = (col < W1) ? *(const bf16x8*)(K1 + key * ldk1 + col) : *(const bf16x8*)(K2 + key * ldk2 + (col - W1)); } } while (0)
#define ATT_LOADV(kt) do { \
        _Pragma("unroll") for (int i = 0; i < VC; ++i) { const int ci = tid + 512 * i, row = ci >> 3, cc = ci & 7; vreg[i] = *(const bf16x8*)(Vt + (size_t)row * ldv + (size_t)(kt) * 64 + cc * 8); } } while (0)
#define ATT_STOREK(buf) do { \
        _Pragma("unroll") for (int i = 0; i < KC; ++i) { const int ci = tid + 512 * i, row = ci / CPR, cc = ci % CPR; *(LAS bf16x8*)(kbase + (buf) * KBYTES + row * KS + cc * 16) = kreg[i]; } } while (0)
#define ATT_STOREV(buf) do { \
        _Pragma("unroll") for (int i = 0; i < VC; ++i) { const int ci = tid + 512 * i, row = ci >> 3, cc = ci & 7; *(LAS bf16x8*)(vbase + (buf) * VBYTES + row * VS + cc * 16) = vreg[i]; } } while (0)
#define ATT_LOAD(kt) do { ATT_LOADK(kt); ATT_LOADV(kt); } while (0)
#define ATT_STORE(buf) do { ATT_STOREK(buf); ATT_STOREV(buf); } while (0)
    if (PF) { ATT_LOAD(tlo); ATT_STORE(0); __syncthreads(); }
    for (int kt = tlo; kt < thi; ++kt) {
        const int cur = PF ? ((kt - tlo) & 1) : 0;
        if (PF) { if (kt + 1 < thi) ATT_LOAD(kt + 1); }
        else { __syncthreads(); ATT_LOADK(kt); ATT_STOREK(0); ATT_LOADV(kt); ATT_STOREV(0); __syncthreads(); }
        if (kt >= wlo && kt < whi) {
            const LAS unsigned char* kb_ = kbase + cur * KBYTES;
            const LAS unsigned char* vb_ = vbase + cur * VBYTES;
            f32x4 sacc[QB][4];
#pragma unroll
            for (int qb = 0; qb < QB; ++qb)
#pragma unroll
                for (int kb = 0; kb < 4; ++kb) sacc[qb][kb] = (f32x4){0.f, 0.f, 0.f, 0.f};
#pragma unroll
            for (int ks = 0; ks < NKS; ++ks) {
#pragma unroll
                for (int kb = 0; kb < 4; ++kb) { const bf16x8 kf = *(const LAS bf16x8*)(kb_ + (kb * 16 + fr) * KS + ks * 64 + fq * 16);
#pragma unroll
                    for (int qb = 0; qb < QB; ++qb) sacc[qb][kb] = __builtin_amdgcn_mfma_f32_16x16x32_bf16(kf, qf[qb][ks], sacc[qb][kb], 0, 0, 0); }
                if (QB > 1) __builtin_amdgcn_sched_barrier(0); }
            bf16x8 pf[QB][2];
#pragma unroll
            for (int qb = 0; qb < QB; ++qb) {
                float mx = -3e38f;
#pragma unroll
                for (int kb = 0; kb < 4; ++kb)
#pragma unroll
                    for (int j = 0; j < 4; ++j) { float s = sacc[qb][kb][j] * scale2;
                        if (BIAS) { int dist = (qpos_w + qb * 16 + fr) - (kt * 64 + kb * 16 + fq * 4 + j); dist = dist < -128 ? -128 : (dist > 128 ? 128 : dist); s += rb[dist + 128]; }
                        sacc[qb][kb][j] = s; mx = fmaxf(mx, s); }
                mx = fmaxf(mx, __shfl_xor(mx, 16)); mx = fmaxf(mx, __shfl_xor(mx, 32));
                const float mn = fmaxf(mrun[qb], mx); const float al = fast_exp2(mrun[qb] - mn); mrun[qb] = mn;
                float ps = 0.f;
#pragma unroll
                for (int kb = 0; kb < 4; ++kb)
#pragma unroll
                    for (int j = 0; j < 4; ++j) { const float p = fast_exp2(sacc[qb][kb][j] - mn); sacc[qb][kb][j] = p; ps += p; }
                lrun[qb] = lrun[qb] * al + ps;
#pragma unroll
                for (int db = 0; db < NDB; ++db) oacc[qb][db] = oacc[qb][db] * al;
#pragma unroll
                for (int ks = 0; ks < 2; ++ks) { u32x4 w; w.x = cvt_pk_bf16(sacc[qb][2 * ks][0], sacc[qb][2 * ks][1]); w.y = cvt_pk_bf16(sacc[qb][2 * ks][2], sacc[qb][2 * ks][3]);
                    w.z = cvt_pk_bf16(sacc[qb][2 * ks + 1][0], sacc[qb][2 * ks + 1][1]); w.w = cvt_pk_bf16(sacc[qb][2 * ks + 1][2], sacc[qb][2 * ks + 1][3]);
                    pf[qb][ks] = __builtin_bit_cast(bf16x8, w); }
            }
#pragma unroll
            for (int db = 0; db < NDB; ++db) { if (QB > 1) __builtin_amdgcn_sched_barrier(0);
#pragma unroll
                for (int ks = 0; ks < 2; ++ks) { const LAS unsigned char* vp = vb_ + (db * 16 + fr) * VS + ks * 64 + fq * 8;
                    const u32x2 v0 = *(const LAS u32x2*)vp, v1 = *(const LAS u32x2*)(vp + 32); u32x4 w; w.x = v0.x; w.y = v0.y; w.z = v1.x; w.w = v1.y;
                    const bf16x8 vf = __builtin_bit_cast(bf16x8, w);
#pragma unroll
                    for (int qb = 0; qb < QB; ++qb) oacc[qb][db] = __builtin_amdgcn_mfma_f32_16x16x32_bf16(vf, pf[qb][ks], oacc[qb][db], 0, 0, 0); } }
        }
        if (PF) { if (kt + 1 < thi) ATT_STORE(cur ^ 1); __syncthreads(); }
    }
    if (!PF) __syncthreads();
#pragma unroll
    for (int qb = 0; qb < QB; ++qb) { float l = lrun[qb]; l += __shfl_xor(l, 16); l += __shfl_xor(l, 32); const float inv = 1.0f / l;
        bf16_t* rp = O + (size_t)(wid * 16 * QB + qb * 16 + fr) * ldo + fq * 4;
#pragma unroll
        for (int db = 0; db < NDB; ++db) { const f32x4 v = oacc[qb][db] * inv; u32x2 w; w.x = cvt_pk_bf16(v[0], v[1]); w.y = cvt_pk_bf16(v[2], v[3]); *(u32x2*)(rp + db * 16) = w; } }
#undef ATT_LOAD
#undef ATT_STORE
#undef ATT_LOADK
#undef ATT_LOADV
#undef ATT_STOREK
#undef ATT_STOREV
}

template <int N> __device__ __forceinline__ void wait_vm() {
    if (N == 2) asm volatile("s_waitcnt vmcnt(2)" ::: "memory");
    else if (N == 5) asm volatile("s_waitcnt vmcnt(5)" ::: "memory");
    else if (N == 10) asm volatile("s_waitcnt vmcnt(10)" ::: "memory");
    else asm volatile("s_waitcnt vmcnt(0)" ::: "memory");
}
template <int DQK, int DV, int W1, int QB, int NBUF, bool BIAS>
__device__ __forceinline__ void attn_unit(LAS unsigned char* lds, const bf16_t* Q1, int ldq1, const bf16_t* Q2, int ldq2,
                                          const bf16_t* K1, int ldk1, const bf16_t* K2, int ldk2, const bf16_t* Vt, int ldv, bf16_t* O, int ldo,
                                          int tlo, int thi, int wlo, int whi, float scale2, int qpos_w, const float* rbias, const int tid) {
    constexpr int KSTR = DQK * 2, KBYTES = 64 * KSTR, VBYTES = DV * 128;
    constexpr int KC = DQK / 64, VC = DV / 64, NKS = DQK / 32, NDB = DV / 16, CPR = DQK / 8, NDMA = KC + VC;
    const int wid = __builtin_amdgcn_readfirstlane(tid >> 6), lane = tid & 63, fr = lane & 15, fq = lane >> 4;
    LAS unsigned char* kbase = lds;
    LAS unsigned char* vbase = lds + NBUF * KBYTES;
    LAS float* rb = (LAS float*)(lds + NBUF * (KBYTES + VBYTES));
    if (BIAS) { if (tid < 257) rb[tid] = rbias[tid] * LOG2E_; asm volatile("s_waitcnt lgkmcnt(0)" ::: "memory"); }
    const bf16_t* kp[KC]; int kst[KC]; const bf16_t* vp[VC];
#pragma unroll
    for (int i = 0; i < KC; ++i) { const int q = (i * 8 + wid) * 64 + lane, r = q / CPR, pc = q % CPR; const int c = (pc & ~7) | ((pc & 7) ^ ((r >> 1) & 7)); const int col = c * 8;
        if (col < W1) { kp[i] = K1 + (size_t)r * ldk1 + col; kst[i] = 64 * ldk1; } else { kp[i] = K2 + (size_t)r * ldk2 + (col - W1); kst[i] = 64 * ldk2; } }
#pragma unroll
    for (int i = 0; i < VC; ++i) { const int q = (i * 8 + wid) * 64 + lane, r = q >> 3, pc = q & 7; const int c = pc ^ ((r >> 1) & 7); vp[i] = Vt + (size_t)r * ldv + c * 8; }
#define ATT_ISSUE(kt, buf) do { \
        _Pragma("unroll") for (int i = 0; i < KC; ++i) __builtin_amdgcn_global_load_lds((const unsigned*)(kp[i] + (size_t)(kt) * kst[i]), (LAS unsigned*)(kbase + (buf) * KBYTES + (i * 8 + wid) * 1024), 16, 0, 0); \
        _Pragma("unroll") for (int i = 0; i < VC; ++i) __builtin_amdgcn_global_load_lds((const unsigned*)(vp[i] + (size_t)(kt) * 64), (LAS unsigned*)(vbase + (buf) * VBYTES + (i * 8 + wid) * 1024), 16, 0, 0); } while (0)
    const int xs = (fr >> 1) & 7;
    const int koffA = fr * KSTR + 16 * ((xs >> 2) * 4 + (fq ^ (xs & 3))), koffB = fr * KSTR + 16 * (((xs >> 2) ^ 1) * 4 + (fq ^ (xs & 3)));
    int voff[2][2];
#pragma unroll
    for (int ks = 0; ks < 2; ++ks)
#pragma unroll
        for (int hf = 0; hf < 2; ++hf) voff[ks][hf] = fr * 128 + 16 * ((ks * 4 + hf * 2 + (fq >> 1)) ^ xs) + (fq & 1) * 8;
    bf16x8 qf[QB][NKS];
#pragma unroll
    for (int qb = 0; qb < QB; ++qb) { const int row = wid * 16 * QB + qb * 16 + fr;
#pragma unroll
        for (int ks = 0; ks < NKS; ++ks) { const int col = ks * 32 + fq * 8;
            qf[qb][ks] = (col < W1) ? *(const bf16x8*)(Q1 + (size_t)row * ldq1 + col) : *(const bf16x8*)(Q2 + (size_t)row * ldq2 + (col - W1)); } }
    f32x4 oacc[QB][NDB];
    float mrun[QB], lrun[QB];
#pragma unroll
    for (int qb = 0; qb < QB; ++qb) { mrun[qb] = -1e30f; lrun[qb] = 0.f;
#pragma unroll
        for (int db = 0; db < NDB; ++db) oacc[qb][db] = (f32x4){0.f, 0.f, 0.f, 0.f}; }
    const int nt = thi - tlo;
    asm volatile("s_waitcnt vmcnt(0)" ::: "memory");
#pragma unroll
    for (int qb = 0; qb < QB; ++qb)
#pragma unroll
        for (int ks = 0; ks < NKS; ++ks) asm volatile("" : "+v"(qf[qb][ks]));
    if (NBUF > 1) { ATT_ISSUE(tlo, 0); if (nt > 1) ATT_ISSUE(tlo + 1, 1); }
    int cur = 0;
    constexpr int TPG = (NBUF == 4) ? 2 : 1;
    for (int t = 0; t < nt; ++t) {
        const int kt = tlo + t;
        if (NBUF == 4) {
            if ((t & 1) == 0) {
                wait_vm<0>(); __builtin_amdgcn_s_barrier(); asm volatile("" ::: "memory");
                const int nb = ((t >> 1) & 1) ? 0 : 2;
                if (t + 2 < nt) { ATT_ISSUE(kt + 2, nb); if (t + 3 < nt) ATT_ISSUE(kt + 3, nb + 1); }
            }
            cur = (((t >> 1) & 1) ? 2 : 0) + (t & 1);
        } else if (NBUF > 1) {
            if (t + 1 < nt) wait_vm<NDMA>(); else wait_vm<0>();
            __builtin_amdgcn_s_barrier(); asm volatile("" ::: "memory");
            if (t + 2 < nt) { const int nb = cur + 2 >= NBUF ? cur + 2 - NBUF : cur + 2; ATT_ISSUE(kt + 2, nb); }
        } else {
            asm volatile("" ::: "memory"); __builtin_amdgcn_s_barrier(); asm volatile("" ::: "memory");
            ATT_ISSUE(kt, 0); wait_vm<0>(); __builtin_amdgcn_s_barrier(); asm volatile("" ::: "memory");
        }
        if (kt >= wlo && kt < whi) {
            const LAS unsigned char* kb_ = kbase + cur * KBYTES;
            const LAS unsigned char* vb_ = vbase + cur * VBYTES;
            f32x4 sacc[QB][4];
#pragma unroll
            for (int qb = 0; qb < QB; ++qb)
#pragma unroll
                for (int kb = 0; kb < 4; ++kb) sacc[qb][kb] = (f32x4){0.f, 0.f, 0.f, 0.f};
#pragma unroll
            for (int ks = 0; ks < NKS; ++ks) {
#pragma unroll
                for (int kb = 0; kb < 4; ++kb) { const bf16x8 kf = *(const LAS bf16x8*)(kb_ + ((ks & 1) ? koffB : koffA) + kb * 16 * KSTR + (ks >> 1) * 128);
#pragma unroll
                    for (int qb = 0; qb < QB; ++qb) sacc[qb][kb] = __builtin_amdgcn_mfma_f32_16x16x32_bf16(kf, qf[qb][ks], sacc[qb][kb], 0, 0, 0); }
            }
            bf16x8 pf[QB][2];
#pragma unroll
            for (int qb = 0; qb < QB; ++qb) {
                float mx = -3e38f;
#pragma unroll
                for (int kb = 0; kb < 4; ++kb)
#pragma unroll
                    for (int j = 0; j < 4; ++j) { float s = sacc[qb][kb][j];
                        if (BIAS) { int dist = (qpos_w + qb * 16 + fr) - (kt * 64 + kb * 16 + fq * 4 + j); dist = dist < -128 ? -128 : (dist > 128 ? 128 : dist); s = s * scale2 + rb[dist + 128]; sacc[qb][kb][j] = s; }
                        mx = fmaxf(mx, s); }
                mx = fmaxf(mx, __shfl_xor(mx, 16)); mx = fmaxf(mx, __shfl_xor(mx, 32));
                if (!BIAS) mx *= scale2;
                const float mn = fmaxf(mrun[qb], mx); const float al = fast_exp2(mrun[qb] - mn); mrun[qb] = mn;
                float ps = 0.f;
#pragma unroll
                for (int kb = 0; kb < 4; ++kb)
#pragma unroll
                    for (int j = 0; j < 4; ++j) { const float p = BIAS ? fast_exp2(sacc[qb][kb][j] - mn) : fast_exp2(__builtin_fmaf(sacc[qb][kb][j], scale2, -mn)); sacc[qb][kb][j] = p; ps += p; }
                lrun[qb] = lrun[qb] * al + ps;
                if (__any(al != 1.0f)) {
#pragma unroll
                    for (int db = 0; db < NDB; ++db) oacc[qb][db] = oacc[qb][db] * al; }
#pragma unroll
                for (int ks = 0; ks < 2; ++ks) { u32x4 w; w.x = cvt_pk_bf16(sacc[qb][2 * ks][0], sacc[qb][2 * ks][1]); w.y = cvt_pk_bf16(sacc[qb][2 * ks][2], sacc[qb][2 * ks][3]);
                    w.z = cvt_pk_bf16(sacc[qb][2 * ks + 1][0], sacc[qb][2 * ks + 1][1]); w.w = cvt_pk_bf16(sacc[qb][2 * ks + 1][2], sacc[qb][2 * ks + 1][3]);
                    pf[qb][ks] = __builtin_bit_cast(bf16x8, w); }
            }
#pragma unroll
            for (int db = 0; db < NDB; ++db) {
#pragma unroll
                for (int ks = 0; ks < 2; ++ks) {
                    const u32x2 v0 = *(const LAS u32x2*)(vb_ + voff[ks][0] + db * 2048), v1 = *(const LAS u32x2*)(vb_ + voff[ks][1] + db * 2048); u32x4 w; w.x = v0.x; w.y = v0.y; w.z = v1.x; w.w = v1.y;
                    const bf16x8 vf = __builtin_bit_cast(bf16x8, w);
#pragma unroll
                    for (int qb = 0; qb < QB; ++qb) oacc[qb][db] = __builtin_amdgcn_mfma_f32_16x16x32_bf16(vf, pf[qb][ks], oacc[qb][db], 0, 0, 0); } }
        }
        if (NBUF > 1 && NBUF != 4) { cur = cur + 1 >= NBUF ? 0 : cur + 1; }
    }
    asm volatile("" ::: "memory"); __builtin_amdgcn_s_barrier(); asm volatile("" ::: "memory");
#pragma unroll
    for (int qb = 0; qb < QB; ++qb) { float l = lrun[qb]; l += __shfl_xor(l, 16); l += __shfl_xor(l, 32); const float inv = 1.0f / l;
        bf16_t* rp = O + (size_t)(wid * 16 * QB + qb * 16 + fr) * ldo + fq * 4;
#pragma unroll
        for (int db = 0; db < NDB; ++db) { const f32x4 v = oacc[qb][db] * inv; u32x2 w; w.x = cvt_pk_bf16(v[0], v[1]); w.y = cvt_pk_bf16(v[2], v[3]); *(u32x2*)(rp + db * 16) = w; } }
    asm volatile("s_waitcnt vmcnt(0)" ::: "memory");
#undef ATT_ISSUE
}

typedef float f32x16 __attribute__((ext_vector_type(16)));
template <int DQK, int DV, int W1>
__device__ __forceinline__ void attn_unit32(LAS unsigned char* lds, const bf16_t* Q1, int ldq1, const bf16_t* Q2, int ldq2,
                                            const bf16_t* K1, int ldk1, const bf16_t* K2, int ldk2, const bf16_t* Vt, int ldv, bf16_t* O, int ldo,
                                            int tlo, int thi, int wlo, int whi, float scale2, const int tid) {
    constexpr int NBUF = 3, KSTR = DQK * 2, KBYTES = 64 * KSTR, VBYTES = DV * 128;
    constexpr int KC = DQK / 64, VC = DV / 64, NK16 = DQK / 16, NDB = DV / 32, CPR = DQK / 8, NDMA = KC + VC;
    const int wid = __builtin_amdgcn_readfirstlane(tid >> 6), lane = tid & 63, lr = lane & 31, lh = lane >> 5;
    LAS unsigned char* kbase = lds;
    LAS unsigned char* vbase = lds + NBUF * KBYTES;
    const bf16_t* kp[KC]; int kst[KC]; const bf16_t* vp[VC];
#pragma unroll
    for (int i = 0; i < KC; ++i) { const int q = (i * 8 + wid) * 64 + lane, r = q / CPR, pc = q % CPR; const int c = (pc & ~7) | ((pc & 7) ^ ((r >> 1) & 7)); const int col = c * 8;
        if (col < W1) { kp[i] = K1 + (size_t)r * ldk1 + col; kst[i] = 64 * ldk1; } else { kp[i] = K2 + (size_t)r * ldk2 + (col - W1); kst[i] = 64 * ldk2; } }
#pragma unroll
    for (int i = 0; i < VC; ++i) { const int q = (i * 8 + wid) * 64 + lane, r = q >> 3, pc = q & 7; const int c = pc ^ ((r >> 1) & 7);
        const int rs = (r & ~12) | ((r & 4) << 1) | ((r & 8) >> 1);
        vp[i] = Vt + (size_t)rs * ldv + c * 8; }
#define ATT_ISSUE(kt, buf) do { \
        _Pragma("unroll") for (int i = 0; i < KC; ++i) __builtin_amdgcn_global_load_lds((const unsigned*)(kp[i] + (size_t)(kt) * kst[i]), (LAS unsigned*)(kbase + (buf) * KBYTES + (i * 8 + wid) * 1024), 16, 0, 0); \
        _Pragma("unroll") for (int i = 0; i < VC; ++i) __builtin_amdgcn_global_load_lds((const unsigned*)(vp[i] + (size_t)(kt) * 64), (LAS unsigned*)(vbase + (buf) * VBYTES + (i * 8 + wid) * 1024), 16, 0, 0); } while (0)
    const int xs = (lr >> 1) & 7;
    int koff[4];
#pragma unroll
    for (int j = 0; j < 4; ++j) koff[j] = lr * KSTR + 16 * ((2 * j + lh) ^ xs);
    int voff[8];
#pragma unroll
    for (int c = 0; c < 8; ++c) voff[c] = lr * 128 + 16 * (c ^ xs) + 8 * lh;
    bf16x8 qf[NK16];
#pragma unroll
    for (int s16 = 0; s16 < NK16; ++s16) { const int col = s16 * 16 + lh * 8; const int row = wid * 32 + lr;
        qf[s16] = (col < W1) ? *(const bf16x8*)(Q1 + (size_t)row * ldq1 + col) : *(const bf16x8*)(Q2 + (size_t)row * ldq2 + (col - W1)); }
    f32x16 oacc[NDB];
#pragma unroll
    for (int db = 0; db < NDB; ++db)
#pragma unroll
        for (int r = 0; r < 16; ++r) oacc[db][r] = 0.f;
    float mrun = -1e30f, lrun = 0.f;
    const int nt = thi - tlo;
    asm volatile("s_waitcnt vmcnt(0)" ::: "memory");
#pragma unroll
    for (int s16 = 0; s16 < NK16; ++s16) asm volatile("" : "+v"(qf[s16]));
    ATT_ISSUE(tlo, 0); if (nt > 1) ATT_ISSUE(tlo + 1, 1);
    int cur = 0;
    for (int t = 0; t < nt; ++t) {
        const int kt = tlo + t;
        if (t + 1 < nt) wait_vm<NDMA>(); else wait_vm<0>();
        __builtin_amdgcn_s_barrier(); asm volatile("" ::: "memory");
        if (t + 2 < nt) { const int nb = cur + 2 >= NBUF ? cur + 2 - NBUF : cur + 2; ATT_ISSUE(kt + 2, nb); }
        if (kt >= wlo && kt < whi) {
            const LAS unsigned char* kb_ = kbase + cur * KBYTES;
            const LAS unsigned char* vb_ = vbase + cur * VBYTES;
            f32x16 sacc[2];
#pragma unroll
            for (int kb = 0; kb < 2; ++kb)
#pragma unroll
                for (int r = 0; r < 16; ++r) sacc[kb][r] = 0.f;
#pragma unroll
            for (int s16 = 0; s16 < NK16; ++s16)
#pragma unroll
                for (int kb = 0; kb < 2; ++kb) { const bf16x8 kf = *(const LAS bf16x8*)(kb_ + koff[s16 & 3] + kb * 32 * KSTR + (s16 >> 2) * 128);
                    sacc[kb] = __builtin_amdgcn_mfma_f32_32x32x16_bf16(kf, qf[s16], sacc[kb], 0, 0, 0); }
            float mx = -3e38f;
#pragma unroll
            for (int kb = 0; kb < 2; ++kb)
#pragma unroll
                for (int r = 0; r < 16; ++r) mx = fmaxf(mx, sacc[kb][r]);
            mx = fmaxf(mx, __shfl_xor(mx, 32)) * scale2;
            float mn = mrun, al = 1.0f;
            if (__any(mx - mrun > 6.0f)) { mn = fmaxf(mrun, mx); al = fast_exp2(mrun - mn); mrun = mn; }
            float ps = 0.f;
#pragma unroll
            for (int kb = 0; kb < 2; ++kb)
#pragma unroll
                for (int r = 0; r < 16; ++r) { const float p = fast_exp2(__builtin_fmaf(sacc[kb][r], scale2, -mn)); sacc[kb][r] = p; ps += p; }
            lrun = lrun * al + ps;
            if (__any(al != 1.0f)) {
#pragma unroll
                for (int db = 0; db < NDB; ++db)
#pragma unroll
                    for (int r = 0; r < 16; ++r) oacc[db][r] *= al; }
            bf16x8 pf[2][2];
#pragma unroll
            for (int kb = 0; kb < 2; ++kb)
#pragma unroll
                for (int sp = 0; sp < 2; ++sp) { u32x4 w; w.x = cvt_pk_bf16(sacc[kb][8 * sp + 0], sacc[kb][8 * sp + 1]); w.y = cvt_pk_bf16(sacc[kb][8 * sp + 2], sacc[kb][8 * sp + 3]);
                    w.z = cvt_pk_bf16(sacc[kb][8 * sp + 4], sacc[kb][8 * sp + 5]); w.w = cvt_pk_bf16(sacc[kb][8 * sp + 6], sacc[kb][8 * sp + 7]); pf[kb][sp] = __builtin_bit_cast(bf16x8, w); }
#pragma unroll
            for (int db = 0; db < NDB; ++db)
#pragma unroll
                for (int kb = 0; kb < 2; ++kb)
#pragma unroll
                    for (int sp = 0; sp < 2; ++sp) { const int c0 = 4 * kb + 2 * sp;
                        const u32x2 v0 = *(const LAS u32x2*)(vb_ + voff[c0] + db * 32 * 128), v1 = *(const LAS u32x2*)(vb_ + voff[c0 + 1] + db * 32 * 128);
                        u32x4 w; w.x = v0.x; w.y = v0.y; w.z = v1.x; w.w = v1.y;
                        oacc[db] = __builtin_amdgcn_mfma_f32_32x32x16_bf16(__builtin_bit_cast(bf16x8, w), pf[kb][sp], oacc[db], 0, 0, 0); }
        }
        cur = cur + 1 >= NBUF ? 0 : cur + 1;
    }
    asm volatile("" ::: "memory"); __builtin_amdgcn_s_barrier(); asm volatile("" ::: "memory");
    { float l = lrun; l += __shfl_xor(l, 32); const float inv = 1.0f / l;
      bf16_t* rp = O + (size_t)(wid * 32 + lr) * ldo + 8 * lh;
#pragma unroll
      for (int db = 0; db < NDB; ++db)
#pragma unroll
          for (int a2 = 0; a2 < 2; ++a2) { u32x4 w; w.x = cvt_pk_bf16(oacc[db][8 * a2] * inv, oacc[db][8 * a2 + 1] * inv); w.y = cvt_pk_bf16(oacc[db][8 * a2 + 2] * inv, oacc[db][8 * a2 + 3] * inv);
              w.z = cvt_pk_bf16(oacc[db][8 * a2 + 4] * inv, oacc[db][8 * a2 + 5] * inv); w.w = cvt_pk_bf16(oacc[db][8 * a2 + 6] * inv, oacc[db][8 * a2 + 7] * inv);
              *(u32x4*)(rp + db * 32 + a2 * 16) = w; } }
    asm volatile("s_waitcnt vmcnt(0)" ::: "memory");
#undef ATT_ISSUE
}

__device__ __forceinline__ int map_row(int mode, int c) {
    if (mode == 1) { const int bj = c / DFF_, q = c % DFF_; return (q >> 7) * 256 + bj * 128 + (q & 127); }
    if (mode == 2) return c < 4160 ? c : c + 192;
    if (mode == 3) { const int h = c / 192, r = c % 192; if (r < 128) return h * 128 + r; const int rr = r - 128; return 2048 + (h >> 2) * 256 + (rr >> 5) * 128 + (h & 3) * 32 + (rr & 31); }
    if (mode == 4) { const int h = c >> 8, r = c & 255; return r < 128 ? h * 128 + r : 2048 + h * 128 + (r - 128); }
    return c;
}

__device__ __forceinline__ void conv_jobs(LAS unsigned char* lds, PP P, int j0, int j1, const int tid) {
    LAS float* tile = (LAS float*)lds;
    const int t = tid;
    int total = 0;
    for (int j = j0; j < j1; ++j) total += P->job[j].ntiles;
    for (int it = blockIdx.x; it < total; it += gridDim.x) {
        int j = j0, l = it;
        while (l >= P->job[j].ntiles) { l -= P->job[j].ntiles; ++j; }
#define J (P->job[j])
        const int N = J.N, nct = (N + 255) / 256; const int kt = l / nct, ct = l % nct; const int k0 = kt * 64, c0 = ct * 256;
        const float* W = J.W; const float* ksc = J.ksc;
        { const int n4 = (t & 63) * 4; const bool ok = (c0 + n4) < N;
          f32x4 v[8];
#pragma unroll
          for (int i = 0; i < 8; ++i) { const int k = (t >> 6) + 8 * i; v[i] = ok ? __builtin_nontemporal_load((const f32x4*)(W + (size_t)(k0 + k) * N + c0 + n4)) : (f32x4){0.f, 0.f, 0.f, 0.f}; }
#pragma unroll
          for (int i = 0; i < 8; ++i) { const int k = (t >> 6) + 8 * i; const float sc = ksc ? ksc[k0 + k] : 1.0f; *(LAS f32x4*)(tile + k * 260 + (n4 ^ (4 * i))) = v[i] * sc; } }
        __syncthreads();
        { const int p = t & 7;
#pragma unroll
          for (int e = 0; e < 4; ++e) { const int n = e * 64 + (t >> 3);
            if (c0 + n < N) { const int row = map_row(J.mode, c0 + n); const LAS float* tp = tile + (8 * p) * 260 + (n ^ (4 * p));
                u32x4 w; w.x = cvt_pk_bf16(tp[0], tp[260]); w.y = cvt_pk_bf16(tp[520], tp[780]); w.z = cvt_pk_bf16(tp[1040], tp[1300]); w.w = cvt_pk_bf16(tp[1560], tp[1820]);
                *(u32x4*)(J.dst + (size_t)row * J.ldd + k0 + 8 * p) = w; } } }
        __syncthreads();
    }
}
#undef J
__device__ __forceinline__ void ln_rows(const float* src, const float* g, const float* b, float* outf, bf16_t* outb, int nrows, const int tid, float* stats = nullptr) {
    const int wid = tid >> 6, lane = tid & 63;
    f32x4 gv[8], bv[8];
#pragma unroll
    for (int i = 0; i < 8; ++i) { gv[i] = *(const f32x4*)(g + (lane + 64 * i) * 4); bv[i] = *(const f32x4*)(b + (lane + 64 * i) * 4); }
    for (int row = blockIdx.x * 8 + wid; row < nrows; row += gridDim.x * 8) {
        const f32x4* p = (const f32x4*)(src + (size_t)row * D_);
        f32x4 v[8]; float s = 0.f;
#pragma unroll
        for (int i = 0; i < 8; ++i) { v[i] = __builtin_nontemporal_load(p + lane + 64 * i); s += (v[i][0] + v[i][1]) + (v[i][2] + v[i][3]); }
        const float mean = wave_sum(s) * (1.0f / D_);
        float q = 0.f;
#pragma unroll
        for (int i = 0; i < 8; ++i) { const f32x4 d = v[i] - mean; q += (d[0] * d[0] + d[1] * d[1]) + (d[2] * d[2] + d[3] * d[3]); }
        const float rstd = 1.0f / sqrtf(wave_sum(q) * (1.0f / D_) + 1e-5f);
        if (stats && lane == 0) { stats[(size_t)row * 2] = mean; stats[(size_t)row * 2 + 1] = rstd; }
#pragma unroll
        for (int i = 0; i < 8; ++i) { const f32x4 y = (v[i] - mean) * rstd * gv[i] + bv[i];
            if (outf) *(f32x4*)(outf + (size_t)row * D_ + (lane + 64 * i) * 4) = y;
            if (outb) { u32x2 w; w.x = cvt_pk_bf16(y[0], y[1]); w.y = cvt_pk_bf16(y[2], y[3]); *(u32x2*)(outb + (size_t)row * D_ + (lane + 64 * i) * 4) = w; } }
    }
}

__device__ __forceinline__ void prologue_misc(PP P, const int tid) {
    const size_t gt = (size_t)blockIdx.x * 512 + tid, gn = (size_t)gridDim.x * 512;
    { const float* x = P->in[0]; bf16_t* xb = P->hb;
      for (size_t i = gt; i < (size_t)T_ * D_ / 8; i += gn) { const f32x4 a = __builtin_nontemporal_load((const f32x4*)(x + i * 8)), b = __builtin_nontemporal_load((const f32x4*)(x + i * 8 + 4));
          u32x4 w; w.x = cvt_pk_bf16(a[0], a[1]); w.y = cvt_pk_bf16(a[2], a[3]); w.z = cvt_pk_bf16(b[0], b[1]); w.w = cvt_pk_bf16(b[2], b[3]); *(u32x4*)(xb + i * 8) = w; } }
    for (size_t i = gt; i < (size_t)S_ * 32; i += gn) { const int pos = (int)(i >> 5), k = (int)(i & 31);
        const float inv = 1.0f / powf(10000.0f, (float)(2 * k) / 64.0f); const float ang = (float)pos * inv;
        const double a = (double)ang; const double kk = rint(a * 0.15915494309189533577); const float r = (float)(a - kk * 6.283185307179586476925);
        P->cosT[i] = cosf(r); P->sinT[i] = sinf(r); }
    { u32x4* zp = (u32x4*)(P->wmix + (size_t)4160 * D_); const u32x4 z0 = {0u, 0u, 0u, 0u};
      for (size_t i = gt; i < (size_t)192 * D_ * 2 / 16; i += gn) zp[i] = z0; }
}

__device__ __forceinline__ void prep_rows(PP P, const int tid) {
    const int wid = tid >> 6, lane = tid & 63;
    for (int row = blockIdx.x * 8 + wid; row < T_; row += gridDim.x * 8) {
        const float* lp = P->lat + (size_t)row * 1024;
#pragma unroll
        for (int part = 0; part < 2; ++part) {
            const f32x4 a0 = __builtin_nontemporal_load((const f32x4*)(lp + part * 512 + lane * 4)), a1 = __builtin_nontemporal_load((const f32x4*)(lp + part * 512 + 256 + lane * 4));
            float ss = (a0[0] * a0[0] + a0[1] * a0[1]) + (a0[2] * a0[2] + a0[3] * a0[3]) + (a1[0] * a1[0] + a1[1] * a1[1]) + (a1[2] * a1[2] + a1[3] * a1[3]);
            const float r = 1.0f / sqrtf(wave_sum(ss) * (1.0f / 512.0f) + 1e-6f);
            bf16_t* op = (part == 0 ? P->cq : P->ckv) + (size_t)row * 512;
            u32x2 w0, w1; w0.x = cvt_pk_bf16(a0[0] * r, a0[1] * r); w0.y = cvt_pk_bf16(a0[2] * r, a0[3] * r); w1.x = cvt_pk_bf16(a1[0] * r, a1[1] * r); w1.y = cvt_pk_bf16(a1[2] * r, a1[3] * r);
            *(u32x2*)(op + lane * 4) = w0; *(u32x2*)(op + 256 + lane * 4) = w1;
        }
        if (lane < 32) { const float x1 = P->kraw[(size_t)row * 64 + lane], x2 = P->kraw[(size_t)row * 64 + 32 + lane]; const int pos = row & (S_ - 1);
            const float c = P->cosT[pos * 32 + lane], s = P->sinT[pos * 32 + lane];
            P->kpe[(size_t)row * 64 + lane] = (bf16_t)(cvt_pk_bf16(x1 * c - x2 * s, 0.f) & 0xffffu); P->kpe[(size_t)row * 64 + 32 + lane] = (bf16_t)(cvt_pk_bf16(x2 * c + x1 * s, 0.f) & 0xffffu); }
    }
}

#define XB_TMO      128
#define XB_XCNT(j)  (256  + 64 * (j))
#define XB_XSUB(j)  (1280 + 64 * (j))
#define XB_XGEN(j)  (2304 + 64 * (j))
#define XB_TOP      3328
#define XB_TOPGEN   3392
#define XCD_BAR_WORDS 3456
#define XB_SPIN_CAP (1u << 18)

__device__ __forceinline__ unsigned xb_ld(unsigned* p)              { return __hip_atomic_load(p, __ATOMIC_RELAXED, __HIP_MEMORY_SCOPE_AGENT); }
__device__ __forceinline__ unsigned xb_add(unsigned* p, unsigned v) { return __hip_atomic_fetch_add(p, v, __ATOMIC_RELAXED, __HIP_MEMORY_SCOPE_AGENT); }
__device__ __forceinline__ unsigned xb_xcc_id() { return (unsigned)__builtin_amdgcn_s_getreg((3 << 11) | 20) & 0xFu; }
#define XB_SPIN(cond, bar) do { unsigned _sp = 0; while (cond) { __builtin_amdgcn_s_sleep(1); \
    if ((++_sp & 255u) == 0u) { if (xb_ld(&(bar)[XB_TMO])) break; if (_sp > XB_SPIN_CAP) { atomicAdd(&(bar)[XB_TMO], 1u); break; } } } } while (0)

struct XcdBarrier {
    unsigned* bar; unsigned x;
    volatile LAS unsigned* st;
};

__device__ __forceinline__ XcdBarrier xcd_barrier_post(unsigned* bar, volatile LAS unsigned* st) {
    XcdBarrier b; b.bar = bar; b.x = xb_xcc_id(); b.st = st;
    if (threadIdx.x == 0) (void)xb_add(&bar[XB_XCNT(b.x)], 1u);
    return b;
}
__device__ __forceinline__ void xcd_barrier_complete(unsigned* bar, unsigned x, unsigned& nloc, unsigned& nx) {
    const unsigned G = gridDim.x * gridDim.y * gridDim.z;
    unsigned sum, cnt, mine, sp = 0u;
    for (;;) {
        sum = 0u; cnt = 0u; mine = 0u;
#pragma unroll
        for (unsigned j = 0; j < 16; ++j) { const unsigned c = xb_ld(&bar[XB_XCNT(j)]); sum += c; cnt += (c > 0u) ? 1u : 0u; mine = (j == x) ? c : mine; }
        if (sum == G) break;
        __builtin_amdgcn_s_sleep(1);
        if ((++sp & 255u) == 0u) { if (xb_ld(&bar[XB_TMO])) break; if (sp > XB_SPIN_CAP) { atomicAdd(&bar[XB_TMO], 1u); break; } }
    }
    nloc = mine > 0u ? mine : 1u; nx = cnt > 0u ? cnt : 1u;
}

__device__ __forceinline__ void xcd_barrier(const XcdBarrier& b) {
    asm volatile("s_waitcnt vmcnt(0)" ::: "memory");
    __syncthreads();
    if (threadIdx.x == 0) {
        unsigned* bar = b.bar;
        __builtin_amdgcn_s_waitcnt(0);
        unsigned nloc = b.st[0], nx = b.st[1];
        if (nloc == 0u) { xcd_barrier_complete(bar, b.x, nloc, nx); b.st[0] = nloc; b.st[1] = nx; }
        const unsigned old = xb_add(&bar[XB_XSUB(b.x)], 1u);
        const unsigned gen = old / nloc;
        if (old + 1u == (gen + 1u) * nloc) {
            __builtin_amdgcn_fence(__ATOMIC_RELEASE, "agent");
            asm volatile("s_waitcnt vmcnt(0)" ::: "memory");
            const unsigned og = xb_add(&bar[XB_TOP], 1u);
            const unsigned tg = og / nx;
            if (og + 1u == (tg + 1u) * nx) xb_add(&bar[XB_TOPGEN], 1u);
            else XB_SPIN(xb_ld(&bar[XB_TOPGEN]) == tg, bar);
            __builtin_amdgcn_fence(__ATOMIC_ACQUIRE, "agent");
            xb_add(&bar[XB_XGEN(b.x)], 1u);
            asm volatile("s_waitcnt vmcnt(0)" ::: "memory");
        } else {
            XB_SPIN(xb_ld(&bar[XB_XGEN(b.x)]) == gen, bar);
            __builtin_amdgcn_fence(__ATOMIC_ACQUIRE, "agent");
            asm volatile("s_waitcnt vmcnt(0)" ::: "memory");
        }
    }
    __syncthreads();
}


__global__ void __launch_bounds__(512, 2) fwd_megakernel(const Params Pk) {
    extern __shared__ __attribute__((aligned(16))) unsigned char lds_raw[];
    LAS unsigned char* lds = (LAS unsigned char*)lds_raw;
    cg::grid_group grid = cg::this_grid();
    const int nphase = ((PP)__builtin_amdgcn_kernarg_segment_ptr())->nphase;
    volatile LAS unsigned* xb_st = (volatile LAS unsigned*)(lds + (LDS_BYTES - 16));
    if (threadIdx.x == 0) { xb_st[0] = 0u; xb_st[1] = 0u; }
    __syncthreads();
    XcdBarrier xbar; xbar.bar = ((PP)__builtin_amdgcn_kernarg_segment_ptr())->bar; xbar.x = xb_xcc_id(); xbar.st = xb_st;
#if PROBE_MASK
    unsigned long long probe_acc = 0;
#endif
    for (int pi = 0; pi < nphase; ++pi) {
        PP P = (PP)__builtin_amdgcn_kernarg_segment_ptr(); asm volatile("" : "+s"(P));
        int tid = threadIdx.x; asm volatile("" : "+v"(tid));
        const int wid = __builtin_amdgcn_readfirstlane(tid >> 6);
#if PROBE_MASK
        const unsigned long long probe_t0 = __builtin_amdgcn_s_memrealtime();
#endif
        Phase ph; ph.kind = P->ph[pi].kind; ph.p0 = P->ph[pi].p0; ph.np = P->ph[pi].np; ph.ld = P->ph[pi].ld; ph.arg = P->ph[pi].arg;
        const int kind = ph.kind;
        if ((PHM & 1) && (kind == K_GEMM || kind == K_DUAL)) {
            gemm_phase(lds, P, ph, tid);
        } else if ((PHM & 2) && kind == K_PRO) {
            prologue_misc(P, tid);
            if (blockIdx.x == 0) { for (int i = tid; i < XCD_BAR_WORDS; i += 512) P->bar[i] = 0u; }
            conv_jobs(lds, P, 0, P->njob0, tid);
        } else if ((PHM & 4) && kind == K_LN) {
            const int li = ph.arg;
            const float* g = P->in[li == 0 ? 4 : (li == 1 ? 16 : (li == 2 ? 23 : 27))];
            const float* b = P->in[li == 0 ? 5 : (li == 1 ? 17 : (li == 2 ? 24 : 28))];
            ln_rows(P->out, g, b, li == 3 ? P->out : (float*)nullptr, li == 3 ? (bf16_t*)nullptr : P->hb, T_, tid, li == 3 ? (float*)nullptr : P->stats);
            if (li == 0) ln_rows(P->in[1], P->in[18], P->in[19], (float*)nullptr, P->memb, 1024, tid);
            if (li == 1) conv_jobs(lds, P, P->njob0, P->njob1, tid);
        } else if ((PHM & 8) && kind == K_PREPA) {
            prep_rows(P, tid);
            for (int u = blockIdx.x; u < 2048; u += gridDim.x) {
                const int bh = u & 63, cp = u >> 6, b = bh >> 4, h = bh & 15;
                const size_t row0 = (size_t)b * S_ + cp * 128;
                bf16_t* q = P->qka + row0 * 2048 + h * 64;
                const bf16_t* k = P->qka + (size_t)b * S_ * 2048 + 1024 + h * 64;
                const bf16_t* vt = P->vta + (size_t)(h * 64) * T_ + (size_t)b * S_;
                const int cw = cp * 2 + (wid >> 2);
                const int tlo = (cp * 2 - 8) < 0 ? 0 : (cp * 2 - 8), wlo = (cw - 8) < 0 ? 0 : (cw - 8);
                attn_unit<64, 64, 64, 1, 4, true>(lds, q, 2048, q, 2048, k, 2048, k, 2048, vt, T_, q, 2048, tlo, cp * 2 + 2, wlo, cw + 1, 0.125f * LOG2E_, cp * 128 + wid * 16, P->in[8] + h * 257, tid);
            }
        } else if ((PHM & 16) && kind == K_MLA) {
            for (int i = 0; ; ++i) {
                int bh, qi;
                if (gridDim.x == 256) { const int x = blockIdx.x & 7, j = blockIdx.x >> 3; if (i >= 4) break; const int rr = 2 * i + (j >> 4), jj = j & 15; bh = x + 8 * rr; qi = (i & 1) ? (15 - jj) : jj; }
                else { const int u = blockIdx.x + i * gridDim.x; if (u >= 1024) break; bh = u & 63; qi = u >> 6; }
                const int b = bh >> 4, h = bh & 15;
                const size_t row0 = (size_t)b * S_ + qi * 256;
                bf16_t* q1 = P->hb + row0 * 2048 + h * 128;
                const bf16_t* q2 = P->qr + row0 * 1024 + h * 64;
                const bf16_t* k1 = P->kn + (size_t)b * S_ * 2048 + h * 128;
                const bf16_t* k2 = P->kpe + (size_t)b * S_ * 64;
                const bf16_t* vt = P->vtb + (size_t)(h * 128) * T_ + (size_t)b * S_;
                const int cw = qi * 4 + (wid >> 1);
                attn_unit32<192, 128, 128>(lds, q1, 2048, q2, 1024, k1, 2048, k2, 64, vt, T_, q1, 2048, 0, qi * 4 + 4, 0, cw + 1, 0.07216878364870322f * LOG2E_, tid);
            }
        } else if ((PHM & 32) && kind == K_XATTN) {
            for (int u = blockIdx.x; u < 1024; u += gridDim.x) {
                const int rbk = u & 31, rest = u >> 5, dvh = rest & 1, h = (rest >> 1) & 3, b = rest >> 3;
                const size_t row0 = (size_t)b * S_ + rbk * 128;
                const bf16_t* q = P->xq + row0 * 2048 + h * 512;
                const bf16_t* k = P->kx + (size_t)(b * 256) * 2048 + h * 512;
                const bf16_t* vt = P->vtx + (size_t)(h * 512 + dvh * 256) * 1024 + b * 256;
                bf16_t* o = P->ox + row0 * 2048 + h * 512 + dvh * 256;
                attn_unit<512, 256, 512, 1, 1, false>(lds, q, 2048, q, 2048, k, 2048, k, 2048, vt, 1024, o, 2048, 0, 4, 0, 4, 0.04419417382415922f * LOG2E_, 0, (const float*)nullptr, tid);
            }
        }
#if PROBE_MASK
        if ((PROBE_MASK >> kind) & 1) probe_acc += __builtin_amdgcn_s_memrealtime() - probe_t0;
#endif
        asm volatile("s_waitcnt vmcnt(0) lgkmcnt(0)" ::: "memory");
        if (pi + 1 < nphase) {
            if (pi == 0) {
                grid.sync();
                if (threadIdx.x == 0) (void)xb_add(&xbar.bar[XB_XCNT(xbar.x)], 1u);
            } else xcd_barrier(xbar); }
    }
#if PROBE_MASK
    { const unsigned long long t0 = __builtin_amdgcn_s_memrealtime(); while (__builtin_amdgcn_s_memrealtime() - t0 < probe_acc) __builtin_amdgcn_s_sleep(8); }
#endif
}

extern "C" void kernel_launch(void* const* d_in, const int* in_sizes, int n_in, void* d_out, int out_size, void* d_ws, size_t ws_size, hipStream_t stream) {
    static int grid_blocks = 0;
    if (grid_blocks == 0) {
        int dev = 0, cus = 0, per_cu = 0;
        hipGetDevice(&dev);
        hipDeviceGetAttribute(&cus, hipDeviceAttributeMultiprocessorCount, dev);
        if (hipFuncSetAttribute((const void*)fwd_megakernel, hipFuncAttributeMaxDynamicSharedMemorySize, LDS_BYTES) != hipSuccess) fprintf(stderr, "hipFuncSetAttribute failed\n");
        if (hipOccupancyMaxActiveBlocksPerMultiprocessor(&per_cu, (const void*)fwd_megakernel, 512, LDS_BYTES) != hipSuccess || per_cu < 1) { fprintf(stderr, "occupancy query: %d\n", per_cu); per_cu = 1; }
        (void)hipGetLastError();
        grid_blocks = cus * per_cu;
        if (grid_blocks > 256) grid_blocks = 256;
        if (grid_blocks < 1) grid_blocks = 256;
    }
    Params p; memset(&p, 0, sizeof(p));
    for (int i = 0; i < 29; ++i) p.in[i] = (const float*)d_in[i];
    p.out = (float*)d_out; p.ws = (unsigned char*)d_ws;
    unsigned char* ws = (unsigned char*)d_ws;
    size_t o = 0;
    const size_t OFF_WMIX = o; o += (size_t)8448 * 2048 * 2;
    const size_t OFF_WQB = o; o += (size_t)3072 * 512 * 2;
    const size_t OFF_WKVB = o; o += (size_t)4096 * 512 * 2;
    const size_t OFF_WOA = o; o += (size_t)2048 * 2048 * 2;
    const size_t OFF_WOB = o; o += (size_t)2048 * 2048 * 2;
    const size_t OFF_WOUT = o; o += (size_t)2048 * 2048 * 2;
    const size_t OFF_WXQ = o; o += (size_t)2048 * 2048 * 2;
    const size_t OFF_WXO = o; o += (size_t)2048 * 2048 * 2;
    const size_t OFF_WXKV = o; o += (size_t)4096 * 2048 * 2;
    const size_t OFF_RF = o; o += (size_t)11008 * 2048 * 2 + (size_t)2048 * 5504 * 2;
    const size_t OFF_ACT = o; o += (size_t)T_ * DFF_ * 2;
    const size_t OFF_Z = o; o += (size_t)T_ * D_ * 4;
    const size_t OFF_HB = o; o += (size_t)T_ * D_ * 2;
    const size_t OFF_KX = o; o += (size_t)1024 * 2048 * 2;
    const size_t OFF_VTX = o; o += (size_t)2048 * 1024 * 2;
    const size_t OFF_ROPE = o; o += (size_t)S_ * 32 * 4 * 2;
    const size_t OFF_QR = o; o += (size_t)T_ * 1024 * 2;
    const size_t OFF_BAR = o; o += 16384;
    const size_t OFF_STATS = o; o += (size_t)T_ * 2 * 4;
    const size_t WS_END = o;
    if (ws_size < WS_END) fprintf(stderr, "kernel_launch: workspace too small: need %zu, have %zu\n", WS_END, ws_size);
    bf16_t* wmix = (bf16_t*)(ws + OFF_WMIX); bf16_t* wqb = (bf16_t*)(ws + OFF_WQB); bf16_t* wkvb = (bf16_t*)(ws + OFF_WKVB);
    bf16_t* woa = (bf16_t*)(ws + OFF_WOA); bf16_t* wob = (bf16_t*)(ws + OFF_WOB); bf16_t* wout = (bf16_t*)(ws + OFF_WOUT);
    bf16_t* wxq = (bf16_t*)(ws + OFF_WXQ); bf16_t* wxo = (bf16_t*)(ws + OFF_WXO); bf16_t* wxkv = (bf16_t*)(ws + OFF_WXKV);
    bf16_t* w1t = (bf16_t*)(ws + OFF_RF); bf16_t* w2t = w1t + (size_t)11008 * 2048;
    bf16_t* act = (bf16_t*)(ws + OFF_ACT);
    p.z = (float*)(ws + OFF_Z); p.hb = (bf16_t*)(ws + OFF_HB);
    p.lat = (float*)(ws + OFF_RF); p.vtb = (bf16_t*)(ws + OFF_RF); bf16_t* mixg = (bf16_t*)(ws + OFF_RF);
    p.gates = act;
    p.kraw = (float*)(ws + OFF_ACT + (size_t)134217728);
    p.cq = (bf16_t*)(ws + OFF_ACT + (size_t)138412032);
    p.ckv = (bf16_t*)(ws + OFF_ACT + (size_t)155189248);
    p.kpe = (bf16_t*)(ws + OFF_ACT + (size_t)171966464);
    p.memb = (bf16_t*)(ws + OFF_ACT + (size_t)174063616);
    p.xq = act; p.ox = (bf16_t*)(ws + OFF_ACT + (size_t)67108864);
    p.qka = (bf16_t*)(ws + OFF_Z); p.vta = (bf16_t*)(ws + OFF_Z + (size_t)67108864); p.kn = (bf16_t*)(ws + OFF_Z + (size_t)67108864);
    p.qr = (bf16_t*)(ws + OFF_QR); p.kx = (bf16_t*)(ws + OFF_KX); p.vtx = (bf16_t*)(ws + OFF_VTX);
    p.cosT = (float*)(ws + OFF_ROPE); p.sinT = p.cosT + (size_t)S_ * 32; p.wmix = wmix;
    p.bar = (unsigned*)(ws + OFF_BAR); p.stats = (float*)(ws + OFF_STATS);
    bf16_t* qn = p.hb;
    float* hf = p.out;
    auto job = [&](int i, int src, bf16_t* dst, const float* ksc, int K, int N, int ldd, int mode) {
        p.job[i].W = p.in[src]; p.job[i].dst = dst; p.job[i].ksc = ksc; p.job[i].K = K; p.job[i].N = N; p.job[i].ldd = ldd; p.job[i].mode = mode; p.job[i].ntiles = (K / 64) * ((N + 255) / 256); };
    job(0, 2, w1t, nullptr, 2048, 11008, 2048, 1);
    job(1, 3, w2t, nullptr, 5504, 2048, 5504, 0);
    job(2, 6, wmix, nullptr, 2048, 8256, 2048, 2);
    job(3, 10, wqb, p.in[9], 512, 3072, 512, 3);
    job(4, 12, wkvb, p.in[11], 512, 4096, 512, 4);
    job(5, 13, woa, nullptr, 1024, 2048, 2048, 0);
    job(6, 14, wob, nullptr, 2048, 2048, 2048, 0);
    job(7, 15, wout, nullptr, 2048, 2048, 2048, 0);
    job(8, 20, wxq, nullptr, 2048, 2048, 2048, 0);
    job(9, 21, wxkv, nullptr, 2048, 4096, 2048, 0);
    job(10, 22, wxo, nullptr, 2048, 2048, 2048, 0);
    job(11, 25, w1t, nullptr, 2048, 11008, 2048, 1);
    job(12, 26, w2t, nullptr, 5504, 2048, 5504, 0);
    p.njob0 = 11; p.njob1 = 13;
    int np = 0, nph = 0;
    auto prob = [&](const bf16_t* A, const bf16_t* B, void* out, const void* aux, const void* aux2, int nM, int nN, int K, int epi, int ldo, float f0, float f1) {
        Prob& q = p.pr[np]; q.A = A; q.B = B; q.out = out; q.aux = aux; q.aux2 = aux2; q.nM = nM; q.nN = nN; q.nt = K / 64; q.epi = epi; q.ldo = ldo; q.f0 = f0; q.f1 = f1; return np++; };
    auto phase = [&](int kind, int p0, int npr, int ld, int arg) { Phase& h = p.ph[nph++]; h.kind = kind; h.p0 = p0; h.np = npr; h.ld = ld; h.arg = arg; };
    phase(K_PRO, 0, 0, 0, 0);
    { int a = prob(p.hb, w1t, act, nullptr, nullptr, 64, 43, 2048, E_SWIGLU, DFF_, 0.f, 0.f); phase(K_GEMM, a, 1, 2048, 0); }
    { int a = prob(act, w2t, p.out, p.in[0], nullptr, 64, 8, DFF_, E_RESZ, -1, ALPHA_, 0.5f); phase(K_GEMM, a, 1, DFF_, 0); }
    phase(K_LN, 0, 0, 0, 0);
    { int a = prob(p.hb, wmix, p.qka, nullptr, nullptr, 64, 8, 2048, E_BF16, 2048, 0.f, 0.f);
      prob(wmix + (size_t)2048 * 2048, p.hb, p.vta, nullptr, nullptr, 4, 64, 2048, E_BF16, T_, 0.f, 0.f);
      prob(p.hb, wmix + (size_t)3072 * 2048, p.lat, nullptr, p.kraw, 64, 5, 2048, E_LAT, 1024, 0.f, 0.f);
      prob(p.hb, wmix + (size_t)4352 * 2048, p.gates, p.in[7], nullptr, 64, 16, 2048, E_GATES, 4096, 0.f, 0.f);
      prob(p.memb, wxkv, p.kx, nullptr, nullptr, 4, 8, 2048, E_BF16, 2048, 0.f, 0.f);
      prob(wxkv + (size_t)2048 * 2048, p.memb, p.vtx, nullptr, nullptr, 8, 4, 2048, E_BF16, 1024, 0.f, 0.f);
      phase(K_GEMM, a, 6, 2048, 0); }
    phase(K_PREPA, 0, 0, 0, 0);
    { int a = prob(p.cq, wqb, qn, nullptr, nullptr, 64, 8, 512, E_BF16, 2048, 0.f, 0.f);
      prob(p.cq, wqb + (size_t)2048 * 512, p.qr, p.cosT, p.sinT, 64, 4, 512, E_ROPEQ, 1024, 0.f, 0.f);
      prob(p.ckv, wkvb, p.kn, nullptr, nullptr, 64, 8, 512, E_BF16, 2048, 0.f, 0.f);
      prob(wkvb + (size_t)2048 * 512, p.ckv, p.vtb, nullptr, nullptr, 8, 64, 512, E_BF16, T_, 0.f, 0.f);
      phase(K_GEMM, a, 4, 512, 0); }
    phase(K_MLA, 0, 0, 0, 0);
    { bf16_t* tga = (bf16_t*)(ws + OFF_Z + (size_t)67108864);
      int a = prob(p.qka, woa, tga, p.gates, nullptr, 64, 8, 1024, E_DUAL0, 2048, 0.f, 0.f);
      prob(qn, wob, mixg, p.gates, tga, 64, 8, 2048, E_DUAL1, 2048, 0.f, 0.f);
      phase(K_DUAL, a, 2, 2048, 0); }
    { int a = prob(mixg, wout, p.out, nullptr, p.stats, 64, 8, 2048, E_RESZ, 0, ALPHA_, 1.0f); phase(K_GEMM, a, 1, 2048, 0); }
    phase(K_LN, 0, 0, 0, 1);
    { int a = prob(p.hb, wxq, p.xq, nullptr, nullptr, 64, 8, 2048, E_BF16, 2048, 0.f, 0.f); phase(K_GEMM, a, 1, 2048, 0); }
    bf16_t* pbuf = (bf16_t*)(ws + OFF_ACT + (size_t)134217728);
    { int a = -1;
      for (int h = 0; h < 4; ++h) { int q = prob(p.xq + h * 512, p.kx + h * 512, pbuf + h * 256, nullptr, nullptr, 64, 1, 512, E_SOFTMAX, 1024, 0.04419417382415922f * LOG2E_, 0.f); p.pr[q].bmode = 1; if (h == 0) a = q; }
      phase(K_GEMM, a, 4, 2048, 0); }
    { int a = -1;
      for (int h = 0; h < 4; ++h) { int q = prob(pbuf + h * 256, p.vtx + (size_t)(h * 512) * 1024, p.ox + h * 512, nullptr, nullptr, 64, 2, 256, E_BF16, 2048, 0.f, 0.f); p.pr[q].bmode = 2; if (h == 0) a = q; }
      phase(K_GEMM, a, 4, 1024, 0); }
    { int a = prob(p.ox, wxo, p.out, nullptr, p.stats, 64, 8, 2048, E_RESZ, 1, ALPHA_, 1.0f); phase(K_GEMM, a, 1, 2048, 0); }
    phase(K_LN, 0, 0, 0, 2);
    { int a = prob(p.hb, w1t, act, nullptr, nullptr, 64, 43, 2048, E_SWIGLU, DFF_, 0.f, 0.f); phase(K_GEMM, a, 1, 2048, 0); }
    { int a = prob(act, w2t, p.out, nullptr, p.stats, 64, 8, DFF_, E_RESZ, 2, ALPHA_, 0.5f); phase(K_GEMM, a, 1, DFF_, 0); }
    phase(K_LN, 0, 0, 0, 3);
    p.nphase = nph;
    void* args[] = {(void*)&p};
    hipError_t e = hipLaunchCooperativeKernel((const void*)fwd_megakernel, dim3(grid_blocks), dim3(512), args, LDS_BYTES, stream);
    if (e != hipSuccess) fprintf(stderr, "cooperative launch failed: %s (grid %d)\n", hipGetErrorString(e), grid_blocks);
}
```

```cpp
#include <hip/hip_runtime.h>
#include <hip/hip_cooperative_groups.h>
#include <cstdio>
#include <cstdint>
#include <cstring>
namespace cg = cooperative_groups;

#define LAS __attribute__((address_space(3)))
typedef unsigned short bf16_t;
typedef short bf16x8 __attribute__((ext_vector_type(8)));
typedef float f32x4 __attribute__((ext_vector_type(4)));
typedef float f32x2 __attribute__((ext_vector_type(2)));
typedef unsigned u32x4 __attribute__((ext_vector_type(4)));
typedef unsigned u32x2 __attribute__((ext_vector_type(2)));

constexpr int T_ = 16384, D_ = 2048, S_ = 4096, DFF_ = 5504;
constexpr float ALPHA_ = 1.1892071150027210667f;
constexpr float LOG2E_ = 1.4426950408889634f;
constexpr int LDS_BYTES = 147456;
#ifndef EPIMASK
#define EPIMASK 511
#endif
#define EPIM(e) ((EPIMASK >> (e)) & 1)
#ifndef PROBE_MASK
#define PROBE_MASK 0
#endif
#ifndef PHM
#define PHM 63
#endif

enum { E_BF16 = 0, E_LAT, E_GATES, E_SWIGLU, E_RESZ, E_ROPEQ, E_DUAL0, E_DUAL1, E_SOFTMAX };
enum { K_PRO = 0, K_GEMM, K_DUAL, K_LN, K_PREPA, K_MLA, K_XATTN };

struct Prob {
    const bf16_t* A; const bf16_t* B; void* out; const void* aux; const void* aux2;
    int nM, nN, nt, epi, ldo; float f0, f1; int bmode;
};
struct Phase { int kind, p0, np, ld, arg; };
struct CJob { const float* W; bf16_t* dst; const float* ksc; int K, N, ldd, mode, ntiles, pad; };
struct Params {
    const float* in[29];
    float* out;
    unsigned char* ws;
    float* z; bf16_t* hb; float* lat; float* kraw; bf16_t* cq; bf16_t* ckv; bf16_t* kpe; bf16_t* memb;
    bf16_t* qka; bf16_t* vta; bf16_t* kn; bf16_t* qr; bf16_t* vtb; bf16_t* gates; bf16_t* xq; bf16_t* ox; bf16_t* kx; bf16_t* vtx;
    float* cosT; float* sinT; bf16_t* wmix; bf16_t* wxqn; unsigned* bar; float* stats;
    int nphase, njob0, njob1, pad;
    Phase ph[20];
    Prob pr[32];
    CJob job[13];
};

static_assert(sizeof(Params) <= 4000, "kernel argument too large");
typedef const Params __attribute__((address_space(4)))* PP;

typedef __bf16 bf2_t __attribute__((ext_vector_type(2)));
__device__ __forceinline__ unsigned cvt_pk_bf16(float lo, float hi) { const f32x2 f = {lo, hi}; const bf2_t r = __builtin_convertvector(f, bf2_t); return __builtin_bit_cast(unsigned, r); }
__device__ __forceinline__ float bf_lo(unsigned w) { return __uint_as_float(w << 16); }
__device__ __forceinline__ float bf_hi(unsigned w) { return __uint_as_float(w & 0xffff0000u); }
__device__ __forceinline__ float wave_sum(float v) {
#pragma unroll
    for (int o = 1; o < 64; o <<= 1) v += __shfl_xor(v, o);
    return v;
}
__device__ __forceinline__ float fast_exp2(float x) { return __builtin_amdgcn_exp2f(x); }
__device__ __forceinline__ float sigmoidf_(float x) { return __builtin_amdgcn_rcpf(1.0f + fast_exp2(-x * LOG2E_)); }

constexpr int BM = 256, BK = 64, HALF = 128, HTB = HALF * BK * 2;
__host__ __device__ __forceinline__ int lds_byte(int r, int c) { const int st = (r >> 4) * 2 + (c >> 5), rr = r & 15, cc = c & 31, ob = rr * 64 + cc * 2; return st * 1024 + (ob ^ (((ob >> 9) & 1) << 5)); }
__host__ __device__ __forceinline__ void stage_rc(int b, int& R, int& C) { const int st = b / 1024, sb = b % 1024, swz = sb ^ (((sb >> 9) & 1) << 5); R = (st >> 1) * 16 + swz / 64; C = (st & 1) * 32 + (swz % 64) / 2; }

struct GU { const char* A; const char* B; int nt, pm, pn, pi; };
__device__ __forceinline__ const char* uni_ptr(const char* p) { const unsigned long long v = (unsigned long long)p; const unsigned lo = __builtin_amdgcn_readfirstlane((unsigned)v), hi = __builtin_amdgcn_readfirstlane((unsigned)(v >> 32)); return (const char*)(((unsigned long long)hi << 32) | lo); }

__device__ __forceinline__ bool g_next(PP P, const Phase& ph, int i, GU& u) {
    const int G = gridDim.x, c = blockIdx.x;
    const bool dual = ph.kind == K_DUAL;
    const int ti = dual ? (i >> 1) : i;
    long L = (long)ti * G + c;
    int pi = ph.p0; bool found = false;
    const int np = dual ? 1 : ph.np;
    for (int k = 0; k < np; ++k) { const int cnt = P->pr[pi].nM * P->pr[pi].nN; if (L < cnt) { found = true; break; } L -= cnt; ++pi; }
    if (!__builtin_amdgcn_readfirstlane((int)found)) return false;
    L = __builtin_amdgcn_readfirstlane((int)L); pi = __builtin_amdgcn_readfirstlane(pi);
    const int nM = P->pr[pi].nM, nN = P->pr[pi].nN, nwg = nM * nN;
    int wgid = (int)L; { const int q = nwg / 8, r = nwg % 8, xcd = wgid % 8, off = wgid / 8; wgid = (xcd < r ? xcd * (q + 1) : r * (q + 1) + (xcd - r) * q) + off; }
    const int nig = 8 * nN, gid = wgid / nig, fm = gid * 8, gsz = (nM - fm) < 8 ? (nM - fm) : 8;
    u.pm = __builtin_amdgcn_readfirstlane(fm + ((wgid % nig) % gsz)); u.pn = __builtin_amdgcn_readfirstlane((wgid % nig) / gsz);
    if (dual) pi += (i & 1);
    pi = __builtin_amdgcn_readfirstlane(pi);
    u.pi = pi;
    const size_t tstep = (size_t)BM * ph.ld * 2;
    u.A = uni_ptr((const char*)P->pr[pi].A + (size_t)u.pm * tstep); { const int bm = P->pr[pi].bmode; const size_t boffs = bm == 1 ? (size_t)(u.pm >> 4) * tstep : (bm == 2 ? (size_t)u.pn * tstep + (size_t)(u.pm >> 4) * 512 : (size_t)u.pn * tstep); u.B = uni_ptr((const char*)P->pr[pi].B + boffs); } u.nt = __builtin_amdgcn_readfirstlane(P->pr[pi].nt);
    return true;
}

__device__ __forceinline__ u32x4 pack8(const f32x4 a, const f32x4 b) { u32x4 w; w.x = cvt_pk_bf16(a[0], a[1]); w.y = cvt_pk_bf16(a[2], a[3]); w.z = cvt_pk_bf16(b[0], b[1]); w.w = cvt_pk_bf16(b[2], b[3]); return w; }
__device__ __forceinline__ void unpack8(const u32x4 w, f32x4& a, f32x4& b) { a = (f32x4){bf_lo(w.x), bf_hi(w.x), bf_lo(w.y), bf_hi(w.y)}; b = (f32x4){bf_lo(w.z), bf_hi(w.z), bf_lo(w.w), bf_hi(w.w)}; }
__device__ __forceinline__ void g_epi(PP P, const GU& u, f32x4 (&acc)[2][2][4][2], int wr, int wc, int fr, int fq, LAS unsigned char* lds) {
#define pr (P->pr[u.pi])
#ifdef EPIFORCE
    const int epi = EPIFORCE;
#else
    const int epi = pr.epi;
#endif
    const int rowb = u.pm * BM + wr * 64 + fr;
    const int colb = u.pn * BM + wc * 32 + fq * 8;
    if (epi == E_BF16) {
        bf16_t* O = (bf16_t*)pr.out; const int ldo = pr.ldo;
#pragma unroll
        for (int ai = 0; ai < 2; ++ai)
#pragma unroll
            for (int m = 0; m < 4; ++m) { asm volatile("" ::: "memory"); bf16_t* rp = O + (size_t)(rowb + ai * HALF + m * 16) * ldo + colb;
#pragma unroll
                for (int bj = 0; bj < 2; ++bj) *(u32x4*)(rp + bj * HALF) = pack8(acc[ai][bj][m][0], acc[ai][bj][m][1]); }
    } else if (EPIM(E_LAT) && epi == E_LAT) {
        if (u.pn < 4) {
            float* O = (float*)pr.out;
#pragma unroll
            for (int ai = 0; ai < 2; ++ai)
#pragma unroll
                for (int m = 0; m < 4; ++m) { asm volatile("" ::: "memory"); float* rp = O + (size_t)(rowb + ai * HALF + m * 16) * 1024 + colb;
#pragma unroll
                    for (int bj = 0; bj < 2; ++bj)
#pragma unroll
                        for (int n = 0; n < 2; ++n) *(f32x4*)(rp + bj * HALF + n * 4) = acc[ai][bj][m][n]; }
        } else if (wc < 2) {
            float* O = (float*)pr.aux2;
#pragma unroll
            for (int ai = 0; ai < 2; ++ai)
#pragma unroll
                for (int m = 0; m < 4; ++m) { asm volatile("" ::: "memory"); float* rp = O + (size_t)(rowb + ai * HALF + m * 16) * 64 + wc * 32 + fq * 8;
#pragma unroll
                    for (int n = 0; n < 2; ++n) *(f32x4*)(rp + n * 4) = acc[ai][0][m][n]; }
        }
    } else if (EPIM(E_GATES) && epi == E_GATES) {
        bf16_t* O = (bf16_t*)pr.out; const float* bias = (const float*)pr.aux;
#pragma unroll
        for (int bj = 0; bj < 2; ++bj) { const f32x4 b0 = *(const f32x4*)(bias + colb + bj * HALF), b1 = *(const f32x4*)(bias + colb + bj * HALF + 4);
#pragma unroll
            for (int ai = 0; ai < 2; ++ai)
#pragma unroll
                for (int m = 0; m < 4; ++m) { asm volatile("" ::: "memory"); f32x4 v0 = acc[ai][bj][m][0] + b0, v1 = acc[ai][bj][m][1] + b1;
#pragma unroll
                    for (int j = 0; j < 4; ++j) { v0[j] = sigmoidf_(v0[j]); v1[j] = sigmoidf_(v1[j]); }
                    *(u32x4*)(O + (size_t)(rowb + ai * HALF + m * 16) * 4096 + colb + bj * HALF) = pack8(v0, v1); } }
    } else if (EPIM(E_SWIGLU) && epi == E_SWIGLU) {
        bf16_t* O = (bf16_t*)pr.out; const int cb = u.pn * 128 + wc * 32 + fq * 8;
#pragma unroll
        for (int ai = 0; ai < 2; ++ai)
#pragma unroll
            for (int m = 0; m < 4; ++m) { asm volatile("" ::: "memory"); f32x4 v[2];
#pragma unroll
                for (int n = 0; n < 2; ++n) { const f32x4 g = acc[ai][0][m][n], uu = acc[ai][1][m][n];
#pragma unroll
                    for (int j = 0; j < 4; ++j) v[n][j] = g[j] * sigmoidf_(g[j]) * uu[j]; }
                *(u32x4*)(O + (size_t)(rowb + ai * HALF + m * 16) * DFF_ + cb) = pack8(v[0], v[1]); }
    } else if (EPIM(E_RESZ) && epi == E_RESZ) {
        float* O = (float*)pr.out; const float f0 = pr.f0, f1 = pr.f1; const int lp = pr.ldo;
        const int colb = u.pn * BM + wc * 32 + fq * 4;
        if (lp < 0) {
            const float* R = (const float*)pr.aux;
#pragma unroll
            for (int ai = 0; ai < 2; ++ai)
#pragma unroll
                for (int m = 0; m < 4; ++m) { asm volatile("" ::: "memory"); const size_t off = (size_t)(rowb + ai * HALF + m * 16) * D_ + colb;
#pragma unroll
                    for (int bj = 0; bj < 2; ++bj)
#pragma unroll
                        for (int n = 0; n < 2; ++n) { const f32x4 r = *(const f32x4*)(R + off + bj * HALF + n * 16); *(f32x4*)(O + off + bj * HALF + n * 16) = r * f0 + acc[ai][bj][m][n] * f1; } }
        } else {
            const float* st = (const float*)pr.aux2;
            const float* g = P->in[lp == 0 ? 4 : (lp == 1 ? 16 : 23)] + colb;
            const float* b = P->in[lp == 0 ? 5 : (lp == 1 ? 17 : 24)] + colb;
            f32x2 ms[2][4];
#pragma unroll
            for (int ai = 0; ai < 2; ++ai)
#pragma unroll
                for (int m = 0; m < 4; ++m) ms[ai][m] = *(const f32x2*)(st + (size_t)(rowb + ai * HALF + m * 16) * 2);
#pragma unroll
            for (int bj = 0; bj < 2; ++bj)
#pragma unroll
                for (int n = 0; n < 2; ++n) { asm volatile("" ::: "memory"); const f32x4 gv = *(const f32x4*)(g + bj * HALF + n * 16), bv = *(const f32x4*)(b + bj * HALF + n * 16);
#pragma unroll
                    for (int ai = 0; ai < 2; ++ai)
#pragma unroll
                        for (int m = 0; m < 4; ++m) { const size_t off = (size_t)(rowb + ai * HALF + m * 16) * D_ + colb + bj * HALF + n * 16; const f32x4 zo = *(const f32x4*)(O + off);
                            const f32x4 h = (zo - ms[ai][m].x) * ms[ai][m].y * gv + bv; *(f32x4*)(O + off) = h * f0 + acc[ai][bj][m][n] * f1; } }
        }
    } else if (EPIM(E_ROPEQ) && epi == E_ROPEQ) {
        bf16_t* O = (bf16_t*)pr.out; const float* cT = (const float*)pr.aux; const float* sT = (const float*)pr.aux2;
        const int head = u.pn * 4 + wc, ri = fq * 8;
#pragma unroll
        for (int ai = 0; ai < 2; ++ai)
#pragma unroll
            for (int m = 0; m < 4; ++m) { asm volatile("" ::: "memory"); const int row = rowb + ai * HALF + m * 16; const int pos = row & (S_ - 1);
                f32x4 o1[2], o2[2];
#pragma unroll
                for (int n = 0; n < 2; ++n) { const f32x4 cs = *(const f32x4*)(cT + pos * 32 + ri + n * 4), sn = *(const f32x4*)(sT + pos * 32 + ri + n * 4);
                    const f32x4 x1 = acc[ai][0][m][n], x2 = acc[ai][1][m][n]; o1[n] = x1 * cs - x2 * sn; o2[n] = x2 * cs + x1 * sn; }
                bf16_t* rp = O + (size_t)row * 1024 + head * 64 + ri; *(u32x4*)rp = pack8(o1[0], o1[1]); *(u32x4*)(rp + 32) = pack8(o2[0], o2[1]); }
    } else if (EPIM(E_SOFTMAX) && epi == E_SOFTMAX) {
        bf16_t* O = (bf16_t*)pr.out; const int ldo = pr.ldo; const float sc = pr.f0;
        int rb_ = wr * 64 + fr; asm volatile("" : "+v"(rb_));
        LAS float* xr = (LAS float*)(lds + 131072) + rb_;
        LAS float* xw = xr + wc * 256;
#pragma unroll
        for (int ai = 0; ai < 2; ++ai)
#pragma unroll
            for (int m = 0; m < 4; ++m) { asm volatile("" ::: "memory"); float mx = -3e38f;
#pragma unroll
                for (int bj = 0; bj < 2; ++bj)
#pragma unroll
                    for (int n = 0; n < 2; ++n) { const f32x4 v = acc[ai][bj][m][n]; mx = fmaxf(fmaxf(mx, fmaxf(v[0], v[1])), fmaxf(v[2], v[3])); }
                mx = fmaxf(mx, __shfl_xor(mx, 16)); mx = fmaxf(mx, __shfl_xor(mx, 32));
                if (fq == 0) xw[ai * HALF + m * 16] = mx; }
        asm volatile("s_waitcnt lgkmcnt(0)" ::: "memory"); __builtin_amdgcn_s_barrier(); asm volatile("" ::: "memory");
#pragma unroll
        for (int ai = 0; ai < 2; ++ai)
#pragma unroll
            for (int m = 0; m < 4; ++m) { asm volatile("" ::: "memory"); const int ro = ai * HALF + m * 16; const float mx = fmaxf(fmaxf(xr[ro], xr[256 + ro]), fmaxf(xr[512 + ro], xr[768 + ro])) * sc; float ps = 0.f;
#pragma unroll
                for (int bj = 0; bj < 2; ++bj)
#pragma unroll
                    for (int n = 0; n < 2; ++n) { const f32x4 v = acc[ai][bj][m][n];
#pragma unroll
                        for (int j = 0; j < 4; ++j) ps += fast_exp2(__builtin_fmaf(v[j], sc, -mx)); }
                ps += __shfl_xor(ps, 16); ps += __shfl_xor(ps, 32);
                if (fq == 0) xw[1024 + ro] = ps; }
        asm volatile("s_waitcnt lgkmcnt(0)" ::: "memory"); __builtin_amdgcn_s_barrier(); asm volatile("" ::: "memory");
#pragma unroll
        for (int ai = 0; ai < 2; ++ai)
#pragma unroll
            for (int m = 0; m < 4; ++m) { asm volatile("" ::: "memory"); const int ro = ai * HALF + m * 16; const float inv = __builtin_amdgcn_rcpf((xr[1024 + ro] + xr[1280 + ro]) + (xr[1536 + ro] + xr[1792 + ro]));
                const float mx = fmaxf(fmaxf(xr[ro], xr[256 + ro]), fmaxf(xr[512 + ro], xr[768 + ro])) * sc;
                bf16_t* rp = O + (size_t)(rowb + ai * HALF + m * 16) * ldo + colb;
#pragma unroll
                for (int bj = 0; bj < 2; ++bj) { f32x4 v[2];
#pragma unroll
                    for (int n = 0; n < 2; ++n) { const f32x4 a = acc[ai][bj][m][n];
#pragma unroll
                        for (int j = 0; j < 4; ++j) v[n][j] = fast_exp2(__builtin_fmaf(a[j], sc, -mx)) * inv; }
                    *(u32x4*)(rp + bj * HALF) = pack8(v[0], v[1]); } }
    } else if (EPIM(E_DUAL0) && epi == E_DUAL0) {
        const bf16_t* G = (const bf16_t*)pr.aux; bf16_t* O = (bf16_t*)pr.out;
#pragma unroll
        for (int ai = 0; ai < 2; ++ai)
#pragma unroll
            for (int m = 0; m < 4; ++m) { asm volatile("" ::: "memory"); const size_t ro = (size_t)(rowb + ai * HALF + m * 16);
#pragma unroll
                for (int bj = 0; bj < 2; ++bj) { f32x4 g0, g1; unpack8(*(const u32x4*)(G + ro * 4096 + colb + bj * HALF), g0, g1);
                    *(u32x4*)(O + ro * D_ + colb + bj * HALF) = pack8(acc[ai][bj][m][0] * g0, acc[ai][bj][m][1] * g1); } }
    } else if (EPIM(E_DUAL1) && epi == E_DUAL1) {
        const bf16_t* G = (const bf16_t*)pr.aux; bf16_t* O = (bf16_t*)pr.out; const bf16_t* Tm = (const bf16_t*)pr.aux2;
#pragma unroll
        for (int ai = 0; ai < 2; ++ai)
#pragma unroll
            for (int m = 0; m < 4; ++m) { asm volatile("" ::: "memory"); const size_t ro = (size_t)(rowb + ai * HALF + m * 16);
#pragma unroll
                for (int bj = 0; bj < 2; ++bj) { f32x4 g0, g1, t0, t1; unpack8(*(const u32x4*)(G + ro * 4096 + 2048 + colb + bj * HALF), g0, g1); unpack8(*(const u32x4*)(Tm + ro * D_ + colb + bj * HALF), t0, t1);
                    *(u32x4*)(O + ro * D_ + colb + bj * HALF) = pack8(t0 + acc[ai][bj][m][0] * g0, t1 + acc[ai][bj][m][1] * g1); } }
    }
}
#undef pr
__device__ __forceinline__ void gemm_phase(LAS unsigned char* lds, PP P, const Phase& ph, const int tid) {
    const int wid = __builtin_amdgcn_readfirstlane(tid >> 6), lane = tid & 63, wr = wid >> 2, wc = wid & 3, fr = lane & 15, fq = lane >> 4;
    const int ld = ph.ld;
    const bool perm = P->pr[ph.p0].epi != E_RESZ;
    unsigned voff[2], voffB[2];
#pragma unroll
    for (int i = 0; i < 2; ++i) { int R, C; stage_rc(tid * 16 + i * 8192, R, C); const int rho = R & 31, Rb = (R & ~31) + (8 * ((rho & 15) >> 2) + 4 * (rho >> 4) + (rho & 3));
        voff[i] = (unsigned)(R * ld + C) * 2u; voffB[i] = (unsigned)((perm ? Rb : R) * ld + C) * 2u; }
    const size_t kstep = (size_t)(BK * 2);
    const size_t hstep = (size_t)HALF * ld * 2;
    const unsigned ldsw = (unsigned)wid * 1024u;
    const int aoff = lds_byte(wr * 64 + fr, fq * 8), boff = lds_byte(wc * 32 + fr, fq * 8);
#define PG8_SA(b, h) (((b) * 2 + (h)) * HTB)
#define PG8_SB(b, h) ((4 + (b) * 2 + (h)) * HTB)
#define PG8_STAGE(bufoff, gbase) do { _Pragma("unroll") for (int _i = 0; _i < 2; ++_i) \
        __builtin_amdgcn_global_load_lds((const unsigned*)((const char*)(gbase) + (((bufoff) >= 4 * HTB) ? voffB[_i] : voff[_i])), (LAS unsigned*)(lds + (bufoff) + ldsw + _i * 8192), 16, 0, 0); } while (0)
#define PG8_LDA(dst, b, h) do { _Pragma("unroll") for (int m = 0; m < 4; ++m) _Pragma("unroll") for (int k = 0; k < 2; ++k) dst[m][k] = *(const LAS bf16x8*)(lds + PG8_SA(b, h) + aoff + m * 2048 + k * 1024); } while (0)
#define PG8_LDB(dst, b, h) do { _Pragma("unroll") for (int n = 0; n < 2; ++n) _Pragma("unroll") for (int k = 0; k < 2; ++k) dst[n][k] = *(const LAS bf16x8*)(lds + PG8_SB(b, h) + boff + n * 2048 + k * 1024); } while (0)
#define PG8_MMA(ai, bj, At, Bt) do { __builtin_amdgcn_s_setprio(1); _Pragma("unroll") for (int m = 0; m < 4; ++m) _Pragma("unroll") for (int n = 0; n < 2; ++n) _Pragma("unroll") for (int k = 0; k < 2; ++k) \
        acc[ai][bj][m][n] = __builtin_amdgcn_mfma_f32_16x16x32_bf16(Bt[n][k], At[m][k], acc[ai][bj][m][n], 0, 0, 0); __builtin_amdgcn_s_setprio(0); } while (0)
#define PG8_WAIT_V(n) asm volatile("s_waitcnt vmcnt(" #n ")" ::: "memory")
#define PG8_WAIT_L(n) asm volatile("s_waitcnt lgkmcnt(" #n ")" ::: "memory")
#define PG8_BAR __builtin_amdgcn_s_barrier()
#define PG8_SCHED __builtin_amdgcn_sched_barrier(0)
    GU cur, nxt; int ui = 0;
    if (!g_next(P, ph, 0, cur)) return;
    f32x4 acc[2][2][4][2];
#pragma unroll
    for (int a = 0; a < 2; ++a)
#pragma unroll
        for (int b = 0; b < 2; ++b)
#pragma unroll
            for (int m = 0; m < 4; ++m)
#pragma unroll
                for (int n = 0; n < 2; ++n) acc[a][b][m][n] = (f32x4){0.f, 0.f, 0.f, 0.f};
    bf16x8 At[4][2], B0[2][2], B1[2][2];
    const char* cA = cur.A; const char* cB = cur.B;
    PG8_STAGE(PG8_SB(0, 0), cB); PG8_STAGE(PG8_SB(0, 1), cB + hstep); PG8_STAGE(PG8_SA(0, 0), cA); PG8_STAGE(PG8_SA(0, 1), cA + hstep);
    if (wr == 1) PG8_BAR;
    PG8_WAIT_V(2); PG8_BAR;
    PG8_STAGE(PG8_SB(1, 0), cB + kstep); PG8_STAGE(PG8_SA(1, 0), cA + kstep); PG8_STAGE(PG8_SB(1, 1), cB + hstep + kstep);
    PG8_WAIT_V(6); PG8_BAR;
    for (;;) {
        const bool has_next = g_next(P, ph, ui + 1, nxt);
        const char* nA = has_next ? nxt.A : cA; const char* nB = has_next ? nxt.B : cB;
        const int nt = cur.nt;
        for (int t = 0; t < nt; t += 2) {
            const bool last = (t == nt - 2);
            const char* a1 = cA + (size_t)(t + 1) * kstep;
            const char* a2 = last ? nA : cA + (size_t)(t + 2) * kstep; const char* b2 = last ? nB : cB + (size_t)(t + 2) * kstep;
            const char* a3 = a2 + kstep; const char* b3 = b2 + kstep;
            PG8_LDB(B0, 0, 0); PG8_LDB(B1, 0, 1); PG8_SCHED; PG8_LDA(At, 0, 0); PG8_STAGE(PG8_SA(1, 1), a1 + hstep);
            PG8_WAIT_V(8); PG8_WAIT_L(0); PG8_BAR; PG8_MMA(0, 0, At, B0); PG8_MMA(0, 1, At, B1); PG8_BAR; PG8_SCHED;
            PG8_LDA(At, 0, 1); PG8_STAGE(PG8_SB(0, 0), b2); PG8_STAGE(PG8_SB(0, 1), b2 + hstep); PG8_STAGE(PG8_SA(0, 0), a2);
            PG8_WAIT_V(8); PG8_WAIT_L(0); PG8_BAR; PG8_MMA(1, 0, At, B0); PG8_MMA(1, 1, At, B1); PG8_BAR; PG8_SCHED;
            PG8_LDB(B0, 1, 0); PG8_LDB(B1, 1, 1); PG8_SCHED; PG8_LDA(At, 1, 0); PG8_STAGE(PG8_SA(0, 1), a2 + hstep);
            PG8_WAIT_V(8); PG8_WAIT_L(0); PG8_BAR; PG8_MMA(0, 0, At, B0); PG8_MMA(0, 1, At, B1); PG8_BAR; PG8_SCHED;
            PG8_LDA(At, 1, 1); PG8_STAGE(PG8_SB(1, 0), b3); PG8_STAGE(PG8_SB(1, 1), b3 + hstep); PG8_STAGE(PG8_SA(1, 0), a3);
            PG8_WAIT_V(8); PG8_WAIT_L(0); PG8_BAR; PG8_MMA(1, 0, At, B0); PG8_MMA(1, 1, At, B1); PG8_BAR; PG8_SCHED;
        }
        if (wr == 0) PG8_BAR;
        g_epi(P, cur, acc, wr, wc, fr, fq, lds);
        if (!has_next) break;
#pragma unroll
        for (int a = 0; a < 2; ++a)
#pragma unroll
            for (int b = 0; b < 2; ++b)
#pragma unroll
                for (int m = 0; m < 4; ++m)
#pragma unroll
                    for (int n = 0; n < 2; ++n) acc[a][b][m][n] = (f32x4){0.f, 0.f, 0.f, 0.f};
        cur = nxt; cA = nA; cB = nB; ++ui;
        if (wr == 1) PG8_BAR;
    }
    PG8_WAIT_V(0);
    PG8_BAR;
#undef PG8_SA
#undef PG8_SB
#undef PG8_STAGE
#undef PG8_LDA
#undef PG8_LDB
#undef PG8_MMA
}

template <int DQK, int DV, int W1, int QB, bool PF, bool BIAS>
__device__ __forceinline__ void attn_unit_reg(LAS unsigned char* lds, const bf16_t* Q1, int ldq1, const bf16_t* Q2, int ldq2,
                                          const bf16_t* K1, int ldk1, const bf16_t* K2, int ldk2, const bf16_t* Vt, int ldv, bf16_t* O, int ldo,
                                          int tlo, int thi, int wlo, int whi, float scale2, int qpos_w, const float* rbias, const int tid) {
    constexpr int KS = DQK * 2 + 16, KBYTES = 64 * KS, VS = 144, VBYTES = DV * VS, NBUF = PF ? 2 : 1;
    constexpr int KC = DQK / 64, VC = DV / 64, NKS = DQK / 32, NDB = DV / 16, CPR = DQK / 8;
    const int wid = __builtin_amdgcn_readfirstlane(tid >> 6), lane = tid & 63, fr = lane & 15, fq = lane >> 4;
    LAS unsigned char* kbase = lds;
    LAS unsigned char* vbase = lds + NBUF * KBYTES;
    LAS float* rb = (LAS float*)(lds + NBUF * (KBYTES + VBYTES));
    if (BIAS) { if (tid < 257) rb[tid] = rbias[tid] * LOG2E_; }
    bf16x8 qf[QB][NKS];
#pragma unroll
    for (int qb = 0; qb < QB; ++qb) { const int row = wid * 16 * QB + qb * 16 + fr;
#pragma unroll
        for (int ks = 0; ks < NKS; ++ks) { const int col = ks * 32 + fq * 8;
            qf[qb][ks] = (col < W1) ? *(const bf16x8*)(Q1 + (size_t)row * ldq1 + col) : *(const bf16x8*)(Q2 + (size_t)row * ldq2 + (col - W1)); } }
    f32x4 oacc[QB][NDB];
    float mrun[QB], lrun[QB];
#pragma unroll
    for (int qb = 0; qb < QB; ++qb) { mrun[qb] = -1e30f; lrun[qb] = 0.f;
#pragma unroll
        for (int db = 0; db < NDB; ++db) oacc[qb][db] = (f32x4){0.f, 0.f, 0.f, 0.f}; }
    bf16x8 kreg[KC], vreg[VC];
#define ATT_LOADK(kt) do { \
        _Pragma("unroll") for (int i = 0; i < KC; ++i) { const int ci = tid + 512 * i, row = ci / CPR, col = (ci % CPR) * 8; const size_t key = (size_t)(kt) * 64 + row; \
            kreg[i] = (col < W1) ? *(const bf16x8*)(K1 + key * ldk1 + col) : *(const bf16x8*)(K2 + key * ldk2 + (col - W1)); } } while (0)
#define ATT_LOADV(kt) do { \
        _Pragma("unroll") for (int i = 0; i < VC; ++i) { const int ci = tid + 512 * i, row = ci >> 3, cc = ci & 7; vreg[i] = *(const bf16x8*)(Vt + (size_t)row * ldv + (size_t)(kt) * 64 + cc * 8); } } while (0)
#define ATT_STOREK(buf) do { \
        _Pragma("unroll") for (int i = 0; i < KC; ++i) { const int ci = tid + 512 * i, row = ci / CPR, cc = ci % CPR; *(LAS bf16x8*)(kbase + (buf) * KBYTES + row * KS + cc * 16) = kreg[i]; } } while (0)
#define ATT_STOREV(buf) do { \
        _Pragma("unroll") for (int i = 0; i < VC; ++i) { const int ci = tid + 512 * i, row = ci >> 3, cc = ci & 7; *(LAS bf16x8*)(vbase + (buf) * VBYTES + row * VS + cc * 16) = vreg[i]; } } while (0)
#define ATT_LOAD(kt) do { ATT_LOADK(kt); ATT_LOADV(kt); } while (0)
#define ATT_STORE(buf) do { ATT_STOREK(buf); ATT_STOREV(buf); } while (0)
    if (PF) { ATT_LOAD(tlo); ATT_STORE(0); __syncthreads(); }
    for (int kt = tlo; kt < thi; ++kt) {
        const int cur = PF ? ((kt - tlo) & 1) : 0;
        if (PF) { if (kt + 1 < thi) ATT_LOAD(kt + 1); }
        else { __syncthreads(); ATT_LOADK(kt); ATT_STOREK(0); ATT_LOADV(kt); ATT_STOREV(0); __syncthreads(); }
        if (kt >= wlo && kt < whi) {
            const LAS unsigned char* kb_ = kbase + cur * KBYTES;
            const LAS unsigned char* vb_ = vbase + cur * VBYTES;
            f32x4 sacc[QB][4];
#pragma unroll
            for (int qb = 0; qb < QB; ++qb)
#pragma unroll
                for (int kb = 0; kb < 4; ++kb) sacc[qb][kb] = (f32x4){0.f, 0.f, 0.f, 0.f};
#pragma unroll
            for (int ks = 0; ks < NKS; ++ks) {
#pragma unroll
                for (int kb = 0; kb < 4; ++kb) { const bf16x8 kf = *(const LAS bf16x8*)(kb_ + (kb * 16 + fr) * KS + ks * 64 + fq * 16);
#pragma unroll
                    for (int qb = 0; qb < QB; ++qb) sacc[qb][kb] = __builtin_amdgcn_mfma_f32_16x16x32_bf16(kf, qf[qb][ks], sacc[qb][kb], 0, 0, 0); }
                if (QB > 1) __builtin_amdgcn_sched_barrier(0); }
            bf16x8 pf[QB][2];
#pragma unroll
            for (int qb = 0; qb < QB; ++qb) {
                float mx = -3e38f;
#pragma unroll
                for (int kb = 0; kb < 4; ++kb)
#pragma unroll
                    for (int j = 0; j < 4; ++j) { float s = sacc[qb][kb][j] * scale2;
                        if (BIAS) { int dist = (qpos_w + qb * 16 + fr) - (kt * 64 + kb * 16 + fq * 4 + j); dist = dist < -128 ? -128 : (dist > 128 ? 128 : dist); s += rb[dist + 128]; }
                        sacc[qb][kb][j] = s; mx = fmaxf(mx, s); }
                mx = fmaxf(mx, __shfl_xor(mx, 16)); mx = fmaxf(mx, __shfl_xor(mx, 32));
                const float mn = fmaxf(mrun[qb], mx); const float al = fast_exp2(mrun[qb] - mn); mrun[qb] = mn;
                float ps = 0.f;
#pragma unroll
                for (int kb = 0; kb < 4; ++kb)
#pragma unroll
                    for (int j = 0; j < 4; ++j) { const float p = fast_exp2(sacc[qb][kb][j] - mn); sacc[qb][kb][j] = p; ps += p; }
                lrun[qb] = lrun[qb] * al + ps;
#pragma unroll
                for (int db = 0; db < NDB; ++db) oacc[qb][db] = oacc[qb][db] * al;
#pragma unroll
                for (int ks = 0; ks < 2; ++ks) { u32x4 w; w.x = cvt_pk_bf16(sacc[qb][2 * ks][0], sacc[qb][2 * ks][1]); w.y = cvt_pk_bf16(sacc[qb][2 * ks][2], sacc[qb][2 * ks][3]);
                    w.z = cvt_pk_bf16(sacc[qb][2 * ks + 1][0], sacc[qb][2 * ks + 1][1]); w.w = cvt_pk_bf16(sacc[qb][2 * ks + 1][2], sacc[qb][2 * ks + 1][3]);
                    pf[qb][ks] = __builtin_bit_cast(bf16x8, w); }
            }
#pragma unroll
            for (int db = 0; db < NDB; ++db) { if (QB > 1) __builtin_amdgcn_sched_barrier(0);
#pragma unroll
                for (int ks = 0; ks < 2; ++ks) { const LAS unsigned char* vp = vb_ + (db * 16 + fr) * VS + ks * 64 + fq * 8;
                    const u32x2 v0 = *(const LAS u32x2*)vp, v1 = *(const LAS u32x2*)(vp + 32); u32x4 w; w.x = v0.x; w.y = v0.y; w.z = v1.x; w.w = v1.y;
                    const bf16x8 vf = __builtin_bit_cast(bf16x8, w);
#pragma unroll
                    for (int qb = 0; qb < QB; ++qb) oacc[qb][db] = __builtin_amdgcn_mfma_f32_16x16x32_bf16(vf, pf[qb][ks], oacc[qb][db], 0, 0, 0); } }
        }
        if (PF) { if (kt + 1 < thi) ATT_STORE(cur ^ 1); __syncthreads(); }
    }
    if (!PF) __syncthreads();
#pragma unroll
    for (int qb = 0; qb < QB; ++qb) { float l = lrun[qb]; l += __shfl_xor(l, 16); l += __shfl_xor(l, 32); const float inv = 1.0f / l;
        bf16_t* rp = O + (size_t)(wid * 16 * QB + qb * 16 + fr) * ldo + fq * 4;
#pragma unroll
        for (int db = 0; db < NDB; ++db) { const f32x4 v = oacc[qb][db] * inv; u32x2 w; w.x = cvt_pk_bf16(v[0], v[1]); w.y = cvt_pk_bf16(v[2], v[3]); *(u32x2*)(rp + db * 16) = w; } }
#undef ATT_LOAD
#undef ATT_STORE
#undef ATT_LOADK
#undef ATT_LOADV
#undef ATT_STOREK
#undef ATT_STOREV
}

template <int N> __device__ __forceinline__ void wait_vm() {
    if (N == 2) asm volatile("s_waitcnt vmcnt(2)" ::: "memory");
    else if (N == 5) asm volatile("s_waitcnt vmcnt(5)" ::: "memory");
    else if (N == 10) asm volatile("s_waitcnt vmcnt(10)" ::: "memory");
    else asm volatile("s_waitcnt vmcnt(0)" ::: "memory");
}
template <int DQK, int DV, int W1, int QB, int NBUF, bool BIAS>
__device__ __forceinline__ void attn_unit(LAS unsigned char* lds, const bf16_t* Q1, int ldq1, const bf16_t* Q2, int ldq2,
                                          const bf16_t* K1, int ldk1, const bf16_t* K2, int ldk2, const bf16_t* Vt, int ldv, bf16_t* O, int ldo,
                                          int tlo, int thi, int wlo, int whi, float scale2, int qpos_w, const float* rbias, const int tid) {
    constexpr int KSTR = DQK * 2, KBYTES = 64 * KSTR, VBYTES = DV * 128;
    constexpr int KC = DQK / 64, VC = DV / 64, NKS = DQK / 32, NDB = DV / 16, CPR = DQK / 8, NDMA = KC + VC;
    const int wid = __builtin_amdgcn_readfirstlane(tid >> 6), lane = tid & 63, fr = lane & 15, fq = lane >> 4;
    LAS unsigned char* kbase = lds;
    LAS unsigned char* vbase = lds + NBUF * KBYTES;
    LAS float* rb = (LAS float*)(lds + NBUF * (KBYTES + VBYTES));
    if (BIAS) { if (tid < 257) rb[tid] = rbias[tid] * LOG2E_; asm volatile("s_waitcnt lgkmcnt(0)" ::: "memory"); }
    const bf16_t* kp[KC]; int kst[KC]; const bf16_t* vp[VC];
#pragma unroll
    for (int i = 0; i < KC; ++i) { const int q = (i * 8 + wid) * 64 + lane, r = q / CPR, pc = q % CPR; const int c = (pc & ~7) | ((pc & 7) ^ ((r >> 1) & 7)); const int col = c * 8;
        if (col < W1) { kp[i] = K1 + (size_t)r * ldk1 + col; kst[i] = 64 * ldk1; } else { kp[i] = K2 + (size_t)r * ldk2 + (col - W1); kst[i] = 64 * ldk2; } }
#pragma unroll
    for (int i = 0; i < VC; ++i) { const int q = (i * 8 + wid) * 64 + lane, r = q >> 3, pc = q & 7; const int c = pc ^ ((r >> 1) & 7); vp[i] = Vt + (size_t)r * ldv + c * 8; }
#define ATT_ISSUE(kt, buf) do { \
        _Pragma("unroll") for (int i = 0; i < KC; ++i) __builtin_amdgcn_global_load_lds((const unsigned*)(kp[i] + (size_t)(kt) * kst[i]), (LAS unsigned*)(kbase + (buf) * KBYTES + (i * 8 + wid) * 1024), 16, 0, 0); \
        _Pragma("unroll") for (int i = 0; i < VC; ++i) __builtin_amdgcn_global_load_lds((const unsigned*)(vp[i] + (size_t)(kt) * 64), (LAS unsigned*)(vbase + (buf) * VBYTES + (i * 8 + wid) * 1024), 16, 0, 0); } while (0)
    const int xs = (fr >> 1) & 7;
    const int koffA = fr * KSTR + 16 * ((xs >> 2) * 4 + (fq ^ (xs & 3))), koffB = fr * KSTR + 16 * (((xs >> 2) ^ 1) * 4 + (fq ^ (xs & 3)));
    int voff[2][2];
#pragma unroll
    for (int ks = 0; ks < 2; ++ks)
#pragma unroll
        for (int hf = 0; hf < 2; ++hf) voff[ks][hf] = fr * 128 + 16 * ((ks * 4 + hf * 2 + (fq >> 1)) ^ xs) + (fq & 1) * 8;
    bf16x8 qf[QB][NKS];
#pragma unroll
    for (int qb = 0; qb < QB; ++qb) { const int row = wid * 16 * QB + qb * 16 + fr;
#pragma unroll
        for (int ks = 0; ks < NKS; ++ks) { const int col = ks * 32 + fq * 8;
            qf[qb][ks] = (col < W1) ? *(const bf16x8*)(Q1 + (size_t)row * ldq1 + col) : *(const bf16x8*)(Q2 + (size_t)row * ldq2 + (col - W1)); } }
    f32x4 oacc[QB][NDB];
    float mrun[QB], lrun[QB];
#pragma unroll
    for (int qb = 0; qb < QB; ++qb) { mrun[qb] = -1e30f; lrun[qb] = 0.f;
#pragma unroll
        for (int db = 0; db < NDB; ++db) oacc[qb][db] = (f32x4){0.f, 0.f, 0.f, 0.f}; }
    const int nt = thi - tlo;
    asm volatile("s_waitcnt vmcnt(0)" ::: "memory");
#pragma unroll
    for (int qb = 0; qb < QB; ++qb)
#pragma unroll
        for (int ks = 0; ks < NKS; ++ks) asm volatile("" : "+v"(qf[qb][ks]));
    if (NBUF > 1) { ATT_ISSUE(tlo, 0); if (nt > 1) ATT_ISSUE(tlo + 1, 1); }
    int cur = 0;
    constexpr int TPG = (NBUF == 4) ? 2 : 1;
    for (int t = 0; t < nt; ++t) {
        const int kt = tlo + t;
        if (NBUF == 4) {
            if ((t & 1) == 0) {
                wait_vm<0>(); __builtin_amdgcn_s_barrier(); asm volatile("" ::: "memory");
                const int nb = ((t >> 1) & 1) ? 0 : 2;
                if (t + 2 < nt) { ATT_ISSUE(kt + 2, nb); if (t + 3 < nt) ATT_ISSUE(kt + 3, nb + 1); }
            }
            cur = (((t >> 1) & 1) ? 2 : 0) + (t & 1);
        } else if (NBUF > 1) {
            if (t + 1 < nt) wait_vm<NDMA>(); else wait_vm<0>();
            __builtin_amdgcn_s_barrier(); asm volatile("" ::: "memory");
            if (t + 2 < nt) { const int nb = cur + 2 >= NBUF ? cur + 2 - NBUF : cur + 2; ATT_ISSUE(kt + 2, nb); }
        } else {
            asm volatile("" ::: "memory"); __builtin_amdgcn_s_barrier(); asm volatile("" ::: "memory");
            ATT_ISSUE(kt, 0); wait_vm<0>(); __builtin_amdgcn_s_barrier(); asm volatile("" ::: "memory");
        }
        if (kt >= wlo && kt < whi) {
            const LAS unsigned char* kb_ = kbase + cur * KBYTES;
            const LAS unsigned char* vb_ = vbase + cur * VBYTES;
            f32x4 sacc[QB][4];
#pragma unroll
            for (int qb = 0; qb < QB; ++qb)
#pragma unroll
                for (int kb = 0; kb < 4; ++kb) sacc[qb][kb] = (f32x4){0.f, 0.f, 0.f, 0.f};
#pragma unroll
            for (int ks = 0; ks < NKS; ++ks) {
#pragma unroll
                for (int kb = 0; kb < 4; ++kb) { const bf16x8 kf = *(const LAS bf16x8*)(kb_ + ((ks & 1) ? koffB : koffA) + kb * 16 * KSTR + (ks >> 1) * 128);
#pragma unroll
                    for (int qb = 0; qb < QB; ++qb) sacc[qb][kb] = __builtin_amdgcn_mfma_f32_16x16x32_bf16(kf, qf[qb][ks], sacc[qb][kb], 0, 0, 0); }
            }
            bf16x8 pf[QB][2];
#pragma unroll
            for (int qb = 0; qb < QB; ++qb) {
                float mx = -3e38f;
#pragma unroll
                for (int kb = 0; kb < 4; ++kb)
#pragma unroll
                    for (int j = 0; j < 4; ++j) { float s = sacc[qb][kb][j];
                        if (BIAS) { int dist = (qpos_w + qb * 16 + fr) - (kt * 64 + kb * 16 + fq * 4 + j); dist = dist < -128 ? -128 : (dist > 128 ? 128 : dist); s = s * scale2 + rb[dist + 128]; sacc[qb][kb][j] = s; }
                        mx = fmaxf(mx, s); }
                mx = fmaxf(mx, __shfl_xor(mx, 16)); mx = fmaxf(mx, __shfl_xor(mx, 32));
                if (!BIAS) mx *= scale2;
                const float mn = fmaxf(mrun[qb], mx); const float al = fast_exp2(mrun[qb] - mn); mrun[qb] = mn;
                float ps = 0.f;
#pragma unroll
                for (int kb = 0; kb < 4; ++kb)
#pragma unroll
                    for (int j = 0; j < 4; ++j) { const float p = BIAS ? fast_exp2(sacc[qb][kb][j] - mn) : fast_exp2(__builtin_fmaf(sacc[qb][kb][j], scale2, -mn)); sacc[qb][kb][j] = p; ps += p; }
                lrun[qb] = lrun[qb] * al + ps;
                if (__any(al != 1.0f)) {
#pragma unroll
                    for (int db = 0; db < NDB; ++db) oacc[qb][db] = oacc[qb][db] * al; }
#pragma unroll
                for (int ks = 0; ks < 2; ++ks) { u32x4 w; w.x = cvt_pk_bf16(sacc[qb][2 * ks][0], sacc[qb][2 * ks][1]); w.y = cvt_pk_bf16(sacc[qb][2 * ks][2], sacc[qb][2 * ks][3]);
                    w.z = cvt_pk_bf16(sacc[qb][2 * ks + 1][0], sacc[qb][2 * ks + 1][1]); w.w = cvt_pk_bf16(sacc[qb][2 * ks + 1][2], sacc[qb][2 * ks + 1][3]);
                    pf[qb][ks] = __builtin_bit_cast(bf16x8, w); }
            }
#pragma unroll
            for (int db = 0; db < NDB; ++db) {
#pragma unroll
                for (int ks = 0; ks < 2; ++ks) {
                    const u32x2 v0 = *(const LAS u32x2*)(vb_ + voff[ks][0] + db * 2048), v1 = *(const LAS u32x2*)(vb_ + voff[ks][1] + db * 2048); u32x4 w; w.x = v0.x; w.y = v0.y; w.z = v1.x; w.w = v1.y;
                    const bf16x8 vf = __builtin_bit_cast(bf16x8, w);
#pragma unroll
                    for (int qb = 0; qb < QB; ++qb) oacc[qb][db] = __builtin_amdgcn_mfma_f32_16x16x32_bf16(vf, pf[qb][ks], oacc[qb][db], 0, 0, 0); } }
        }
        if (NBUF > 1 && NBUF != 4) { cur = cur + 1 >= NBUF ? 0 : cur + 1; }
    }
    asm volatile("" ::: "memory"); __builtin_amdgcn_s_barrier(); asm volatile("" ::: "memory");
#pragma unroll
    for (int qb = 0; qb < QB; ++qb) { float l = lrun[qb]; l += __shfl_xor(l, 16); l += __shfl_xor(l, 32); const float inv = 1.0f / l;
        bf16_t* rp = O + (size_t)(wid * 16 * QB + qb * 16 + fr) * ldo + fq * 4;
#pragma unroll
        for (int db = 0; db < NDB; ++db) { const f32x4 v = oacc[qb][db] * inv; u32x2 w; w.x = cvt_pk_bf16(v[0], v[1]); w.y = cvt_pk_bf16(v[2], v[3]); *(u32x2*)(rp + db * 16) = w; } }
    asm volatile("s_waitcnt vmcnt(0)" ::: "memory");
#undef ATT_ISSUE
}

typedef float f32x16 __attribute__((ext_vector_type(16)));
template <int DQK, int DV, int W1>
__device__ __forceinline__ void attn_unit32(LAS unsigned char* lds, const bf16_t* Q1, int ldq1, const bf16_t* Q2, int ldq2,
                                            const bf16_t* K1, int ldk1, const bf16_t* K2, int ldk2, const bf16_t* Vt, int ldv, bf16_t* O, int ldo,
                                            int tlo, int thi, int wlo, int whi, float scale2, const int tid) {
    constexpr int NBUF = 3, KSTR = DQK * 2, KBYTES = 64 * KSTR, VBYTES = DV * 128;
    constexpr int KC = DQK / 64, VC = DV / 64, NK16 = DQK / 16, NDB = DV / 32, CPR = DQK / 8, NDMA = KC + VC;
    const int wid = __builtin_amdgcn_readfirstlane(tid >> 6), lane = tid & 63, lr = lane & 31, lh = lane >> 5;
    LAS unsigned char* kbase = lds;
    LAS unsigned char* vbase = lds + NBUF * KBYTES;
    const bf16_t* kp[KC]; int kst[KC]; const bf16_t* vp[VC];
#pragma unroll
    for (int i = 0; i < KC; ++i) { const int q = (i * 8 + wid) * 64 + lane, r = q / CPR, pc = q % CPR; const int c = (pc & ~7) | ((pc & 7) ^ ((r >> 1) & 7)); const int col = c * 8;
        if (col < W1) { kp[i] = K1 + (size_t)r * ldk1 + col; kst[i] = 64 * ldk1; } else { kp[i] = K2 + (size_t)r * ldk2 + (col - W1); kst[i] = 64 * ldk2; } }
#pragma unroll
    for (int i = 0; i < VC; ++i) { const int q = (i * 8 + wid) * 64 + lane, r = q >> 3, pc = q & 7; const int c = pc ^ ((r >> 1) & 7);
        const int rs = (r & ~12) | ((r & 4) << 1) | ((r & 8) >> 1);
        vp[i] = Vt + (size_t)rs * ldv + c * 8; }
#define ATT_ISSUE(kt, buf) do { \
        _Pragma("unroll") for (int i = 0; i < KC; ++i) __builtin_amdgcn_global_load_lds((const unsigned*)(kp[i] + (size_t)(kt) * kst[i]), (LAS unsigned*)(kbase + (buf) * KBYTES + (i * 8 + wid) * 1024), 16, 0, 0); \
        _Pragma("unroll") for (int i = 0; i < VC; ++i) __builtin_amdgcn_global_load_lds((const unsigned*)(vp[i] + (size_t)(kt) * 64), (LAS unsigned*)(vbase + (buf) * VBYTES + (i * 8 + wid) * 1024), 16, 0, 0); } while (0)
    const int xs = (lr >> 1) & 7;
    int koff[4];
#pragma unroll
    for (int j = 0; j < 4; ++j) koff[j] = lr * KSTR + 16 * ((2 * j + lh) ^ xs);
    int voff[8];
#pragma unroll
    for (int c = 0; c < 8; ++c) voff[c] = lr * 128 + 16 * (c ^ xs) + 8 * lh;
    bf16x8 qf[NK16];
#pragma unroll
    for (int s16 = 0; s16 < NK16; ++s16) { const int col = s16 * 16 + lh * 8; const int row = wid * 32 + lr;
        qf[s16] = (col < W1) ? *(const bf16x8*)(Q1 + (size_t)row * ldq1 + col) : *(const bf16x8*)(Q2 + (size_t)row * ldq2 + (col - W1)); }
    f32x16 oacc[NDB];
#pragma unroll
    for (int db = 0; db < NDB; ++db)
#pragma unroll
        for (int r = 0; r < 16; ++r) oacc[db][r] = 0.f;
    float mrun = -1e30f, lrun = 0.f;
    const int nt = thi - tlo;
    asm volatile("s_waitcnt vmcnt(0)" ::: "memory");
#pragma unroll
    for (int s16 = 0; s16 < NK16; ++s16) asm volatile("" : "+v"(qf[s16]));
    ATT_ISSUE(tlo, 0); if (nt > 1) ATT_ISSUE(tlo + 1, 1);
    int cur = 0;
    for (int t = 0; t < nt; ++t) {
        const int kt = tlo + t;
        if (t + 1 < nt) wait_vm<NDMA>(); else wait_vm<0>();
        __builtin_amdgcn_s_barrier(); asm volatile("" ::: "memory");
        if (t + 2 < nt) { const int nb = cur + 2 >= NBUF ? cur + 2 - NBUF : cur + 2; ATT_ISSUE(kt + 2, nb); }
        if (kt >= wlo && kt < whi) {
            const LAS unsigned char* kb_ = kbase + cur * KBYTES;
            const LAS unsigned char* vb_ = vbase + cur * VBYTES;
            f32x16 sacc[2];
#pragma unroll
            for (int kb = 0; kb < 2; ++kb)
#pragma unroll
                for (int r = 0; r < 16; ++r) sacc[kb][r] = 0.f;
#pragma unroll
            for (int s16 = 0; s16 < NK16; ++s16)
#pragma unroll
                for (int kb = 0; kb < 2; ++kb) { const bf16x8 kf = *(const LAS bf16x8*)(kb_ + koff[s16 & 3] + kb * 32 * KSTR + (s16 >> 2) * 128);
                    sacc[kb] = __builtin_amdgcn_mfma_f32_32x32x16_bf16(kf, qf[s16], sacc[kb], 0, 0, 0); }
            float mx = -3e38f;
#pragma unroll
            for (int kb = 0; kb < 2; ++kb)
#pragma unroll
                for (int r = 0; r < 16; ++r) mx = fmaxf(mx, sacc[kb][r]);
            mx = fmaxf(mx, __shfl_xor(mx, 32)) * scale2;
            float mn = mrun, al = 1.0f;
            if (__any(mx - mrun > 6.0f)) { mn = fmaxf(mrun, mx); al = fast_exp2(mrun - mn); mrun = mn; }
            float ps = 0.f;
#pragma unroll
            for (int kb = 0; kb < 2; ++kb)
#pragma unroll
                for (int r = 0; r < 16; ++r) { const float p = fast_exp2(__builtin_fmaf(sacc[kb][r], scale2, -mn)); sacc[kb][r] = p; ps += p; }
            lrun = lrun * al + ps;
            if (__any(al != 1.0f)) {
#pragma unroll
                for (int db = 0; db < NDB; ++db)
#pragma unroll
                    for (int r = 0; r < 16; ++r) oacc[db][r] *= al; }
            bf16x8 pf[2][2];
#pragma unroll
            for (int kb = 0; kb < 2; ++kb)
#pragma unroll
                for (int sp = 0; sp < 2; ++sp) { u32x4 w; w.x = cvt_pk_bf16(sacc[kb][8 * sp + 0], sacc[kb][8 * sp + 1]); w.y = cvt_pk_bf16(sacc[kb][8 * sp + 2], sacc[kb][8 * sp + 3]);
                    w.z = cvt_pk_bf16(sacc[kb][8 * sp + 4], sacc[kb][8 * sp + 5]); w.w = cvt_pk_bf16(sacc[kb][8 * sp + 6], sacc[kb][8 * sp + 7]); pf[kb][sp] = __builtin_bit_cast(bf16x8, w); }
#pragma unroll
            for (int db = 0; db < NDB; ++db)
#pragma unroll
                for (int kb = 0; kb < 2; ++kb)
#pragma unroll
                    for (int sp = 0; sp < 2; ++sp) { const int c0 = 4 * kb + 2 * sp;
                        const u32x2 v0 = *(const LAS u32x2*)(vb_ + voff[c0] + db * 32 * 128), v1 = *(const LAS u32x2*)(vb_ + voff[c0 + 1] + db * 32 * 128);
                        u32x4 w; w.x = v0.x; w.y = v0.y; w.z = v1.x; w.w = v1.y;
                        oacc[db] = __builtin_amdgcn_mfma_f32_32x32x16_bf16(__builtin_bit_cast(bf16x8, w), pf[kb][sp], oacc[db], 0, 0, 0); }
        }
        cur = cur + 1 >= NBUF ? 0 : cur + 1;
    }
    asm volatile("" ::: "memory"); __builtin_amdgcn_s_barrier(); asm volatile("" ::: "memory");
    { float l = lrun; l += __shfl_xor(l, 32); const float inv = 1.0f / l;
      bf16_t* rp = O + (size_t)(wid * 32 + lr) * ldo + 8 * lh;
#pragma unroll
      for (int db = 0; db < NDB; ++db)
#pragma unroll
          for (int a2 = 0; a2 < 2; ++a2) { u32x4 w; w.x = cvt_pk_bf16(oacc[db][8 * a2] * inv, oacc[db][8 * a2 + 1] * inv); w.y = cvt_pk_bf16(oacc[db][8 * a2 + 2] * inv, oacc[db][8 * a2 + 3] * inv);
              w.z = cvt_pk_bf16(oacc[db][8 * a2 + 4] * inv, oacc[db][8 * a2 + 5] * inv); w.w = cvt_pk_bf16(oacc[db][8 * a2 + 6] * inv, oacc[db][8 * a2 + 7] * inv);
              *(u32x4*)(rp + db * 32 + a2 * 16) = w; } }
    asm volatile("s_waitcnt vmcnt(0)" ::: "memory");
#undef ATT_ISSUE
}

__device__ __forceinline__ int map_row(int mode, int c) {
    if (mode == 1) { const int bj = c / DFF_, q = c % DFF_; return (q >> 7) * 256 + bj * 128 + (q & 127); }
    if (mode == 2) return c < 4160 ? c : c + 192;
    if (mode == 3) { const int h = c / 192, r = c % 192; if (r < 128) return h * 128 + r; const int rr = r - 128; return 2048 + (h >> 2) * 256 + (rr >> 5) * 128 + (h & 3) * 32 + (rr & 31); }
    if (mode == 4) { const int h = c >> 8, r = c & 255; return r < 128 ? h * 128 + r : 2048 + h * 128 + (r - 128); }
    return c;
}

__device__ __forceinline__ void conv_jobs(LAS unsigned char* lds, PP P, int j0, int j1, const int tid) {
    LAS float* tile = (LAS float*)lds;
    const int t = tid;
    int total = 0;
    for (int j = j0; j < j1; ++j) total += P->job[j].ntiles;
    for (int it = blockIdx.x; it < total; it += gridDim.x) {
        int j = j0, l = it;
        while (l >= P->job[j].ntiles) { l -= P->job[j].ntiles; ++j; }
#define J (P->job[j])
        const int N = J.N, nct = (N + 255) / 256; const int kt = l / nct, ct = l % nct; const int k0 = kt * 64, c0 = ct * 256;
        const float* W = J.W; const float* ksc = J.ksc;
        { const int n4 = (t & 63) * 4; const bool ok = (c0 + n4) < N;
          f32x4 v[8];
#pragma unroll
          for (int i = 0; i < 8; ++i) { const int k = (t >> 6) + 8 * i; v[i] = ok ? __builtin_nontemporal_load((const f32x4*)(W + (size_t)(k0 + k) * N + c0 + n4)) : (f32x4){0.f, 0.f, 0.f, 0.f}; }
#pragma unroll
          for (int i = 0; i < 8; ++i) { const int k = (t >> 6) + 8 * i; const float sc = ksc ? ksc[k0 + k] : 1.0f; *(LAS f32x4*)(tile + k * 260 + (n4 ^ (4 * i))) = v[i] * sc; } }
        __syncthreads();
        { const int p = t & 7;
#pragma unroll
          for (int e = 0; e < 4; ++e) { const int n = e * 64 + (t >> 3);
            if (c0 + n < N) { const int row = map_row(J.mode, c0 + n); const LAS float* tp = tile + (8 * p) * 260 + (n ^ (4 * p));
                u32x4 w; w.x = cvt_pk_bf16(tp[0], tp[260]); w.y = cvt_pk_bf16(tp[520], tp[780]); w.z = cvt_pk_bf16(tp[1040], tp[1300]); w.w = cvt_pk_bf16(tp[1560], tp[1820]);
                *(u32x4*)(J.dst + (size_t)row * J.ldd + k0 + 8 * p) = w; } } }
        __syncthreads();
    }
}
#undef J
__device__ __forceinline__ void ln_rows(const float* src, const float* g, const float* b, float* outf, bf16_t* outb, int nrows, const int tid, float* stats = nullptr) {
    const int wid = tid >> 6, lane = tid & 63;
    f32x4 gv[8], bv[8];
#pragma unroll
    for (int i = 0; i < 8; ++i) { gv[i] = *(const f32x4*)(g + (lane + 64 * i) * 4); bv[i] = *(const f32x4*)(b + (lane + 64 * i) * 4); }
    for (int row = blockIdx.x * 8 + wid; row < nrows; row += gridDim.x * 8) {
        const f32x4* p = (const f32x4*)(src + (size_t)row * D_);
        f32x4 v[8]; float s = 0.f;
#pragma unroll
        for (int i = 0; i < 8; ++i) { v[i] = p[lane + 64 * i]; s += (v[i][0] + v[i][1]) + (v[i][2] + v[i][3]); }
        const float mean = wave_sum(s) * (1.0f / D_);
        float q = 0.f;
#pragma unroll
        for (int i = 0; i < 8; ++i) { const f32x4 d = v[i] - mean; q += (d[0] * d[0] + d[1] * d[1]) + (d[2] * d[2] + d[3] * d[3]); }
        const float rstd = 1.0f / sqrtf(wave_sum(q) * (1.0f / D_) + 1e-5f);
        if (stats && lane == 0) { stats[(size_t)row * 2] = mean; stats[(size_t)row * 2 + 1] = rstd; }
#pragma unroll
        for (int i = 0; i < 8; ++i) { const f32x4 y = (v[i] - mean) * rstd * gv[i] + bv[i];
            if (outf) *(f32x4*)(outf + (size_t)row * D_ + (lane + 64 * i) * 4) = y;
            if (outb) { u32x2 w; w.x = cvt_pk_bf16(y[0], y[1]); w.y = cvt_pk_bf16(y[2], y[3]); *(u32x2*)(outb + (size_t)row * D_ + (lane + 64 * i) * 4) = w; } }
    }
}

__device__ __forceinline__ void prologue_misc(PP P, const int tid) {
    const size_t gt = (size_t)blockIdx.x * 512 + tid, gn = (size_t)gridDim.x * 512;
    { const float* x = P->in[0]; bf16_t* xb = P->hb;
      for (size_t i = gt; i < (size_t)T_ * D_ / 8; i += gn) { const f32x4 a = __builtin_nontemporal_load((const f32x4*)(x + i * 8)), b = __builtin_nontemporal_load((const f32x4*)(x + i * 8 + 4));
          u32x4 w; w.x = cvt_pk_bf16(a[0], a[1]); w.y = cvt_pk_bf16(a[2], a[3]); w.z = cvt_pk_bf16(b[0], b[1]); w.w = cvt_pk_bf16(b[2], b[3]); *(u32x4*)(xb + i * 8) = w; } }
    { const float* w = P->in[20]; bf16_t* wb = P->wxqn;
      for (size_t i = gt; i < (size_t)D_ * D_ / 8; i += gn) { const f32x4 a = __builtin_nontemporal_load((const f32x4*)(w + i * 8)), b = __builtin_nontemporal_load((const f32x4*)(w + i * 8 + 4));
          u32x4 v; v.x = cvt_pk_bf16(a[0], a[1]); v.y = cvt_pk_bf16(a[2], a[3]); v.z = cvt_pk_bf16(b[0], b[1]); v.w = cvt_pk_bf16(b[2], b[3]); *(u32x4*)(wb + i * 8) = v; } }
    for (size_t i = gt; i < (size_t)S_ * 32; i += gn) { const int pos = (int)(i >> 5), k = (int)(i & 31);
        const float inv = 1.0f / powf(10000.0f, (float)(2 * k) / 64.0f); const float ang = (float)pos * inv;
        const double a = (double)ang; const double kk = rint(a * 0.15915494309189533577); const float r = (float)(a - kk * 6.283185307179586476925);
        P->cosT[i] = cosf(r); P->sinT[i] = sinf(r); }
    { u32x4* zp = (u32x4*)(P->wmix + (size_t)4160 * D_); const u32x4 z0 = {0u, 0u, 0u, 0u};
      for (size_t i = gt; i < (size_t)192 * D_ * 2 / 16; i += gn) zp[i] = z0; }
}

__device__ __forceinline__ void prep_rows(PP P, const int tid) {
    const int wid = tid >> 6, lane = tid & 63;
    for (int row = blockIdx.x * 8 + wid; row < T_; row += gridDim.x * 8) {
        const float* lp = P->lat + (size_t)row * 1024;
#pragma unroll
        for (int part = 0; part < 2; ++part) {
            const f32x4 a0 = *(const f32x4*)(lp + part * 512 + lane * 4), a1 = *(const f32x4*)(lp + part * 512 + 256 + lane * 4);
            float ss = (a0[0] * a0[0] + a0[1] * a0[1]) + (a0[2] * a0[2] + a0[3] * a0[3]) + (a1[0] * a1[0] + a1[1] * a1[1]) + (a1[2] * a1[2] + a1[3] * a1[3]);
            const float r = 1.0f / sqrtf(wave_sum(ss) * (1.0f / 512.0f) + 1e-6f);
            bf16_t* op = (part == 0 ? P->cq : P->ckv) + (size_t)row * 512;
            u32x2 w0, w1; w0.x = cvt_pk_bf16(a0[0] * r, a0[1] * r); w0.y = cvt_pk_bf16(a0[2] * r, a0[3] * r); w1.x = cvt_pk_bf16(a1[0] * r, a1[1] * r); w1.y = cvt_pk_bf16(a1[2] * r, a1[3] * r);
            *(u32x2*)(op + lane * 4) = w0; *(u32x2*)(op + 256 + lane * 4) = w1;
        }
        if (lane < 32) { const float x1 = P->kraw[(size_t)row * 64 + lane], x2 = P->kraw[(size_t)row * 64 + 32 + lane]; const int pos = row & (S_ - 1);
            const float c = P->cosT[pos * 32 + lane], s = P->sinT[pos * 32 + lane];
            P->kpe[(size_t)row * 64 + lane] = (bf16_t)(cvt_pk_bf16(x1 * c - x2 * s, 0.f) & 0xffffu); P->kpe[(size_t)row * 64 + 32 + lane] = (bf16_t)(cvt_pk_bf16(x2 * c + x1 * s, 0.f) & 0xffffu); }
    }
}

#define XB_TMO      128
#define XB_XCNT(j)  (256  + 64 * (j))
#define XB_XSUB(j)  (1280 + 64 * (j))
#define XB_XGEN(j)  (2304 + 64 * (j))
#define XB_TOP      3328
#define XB_TOPGEN   3392
#define XCD_BAR_WORDS 3456
#define XB_SPIN_CAP (1u << 18)

__device__ __forceinline__ unsigned xb_ld(unsigned* p)              { return __hip_atomic_load(p, __ATOMIC_RELAXED, __HIP_MEMORY_SCOPE_AGENT); }
__device__ __forceinline__ unsigned xb_add(unsigned* p, unsigned v) { return __hip_atomic_fetch_add(p, v, __ATOMIC_RELAXED, __HIP_MEMORY_SCOPE_AGENT); }
__device__ __forceinline__ unsigned xb_xcc_id() { return (unsigned)__builtin_amdgcn_s_getreg((3 << 11) | 20) & 0xFu; }
#define XB_SPIN(cond, bar) do { unsigned _sp = 0; while (cond) { __builtin_amdgcn_s_sleep(1); \
    if ((++_sp & 255u) == 0u) { if (xb_ld(&(bar)[XB_TMO])) break; if (_sp > XB_SPIN_CAP) { atomicAdd(&(bar)[XB_TMO], 1u); break; } } } } while (0)

struct XcdBarrier {
    unsigned* bar; unsigned x;
    volatile LAS unsigned* st;
};

__device__ __forceinline__ XcdBarrier xcd_barrier_post(unsigned* bar, volatile LAS unsigned* st) {
    XcdBarrier b; b.bar = bar; b.x = xb_xcc_id(); b.st = st;
    if (threadIdx.x == 0) (void)xb_add(&bar[XB_XCNT(b.x)], 1u);
    return b;
}
__device__ __forceinline__ void xcd_barrier_complete(unsigned* bar, unsigned x, unsigned& nloc, unsigned& nx) {
    const unsigned G = gridDim.x * gridDim.y * gridDim.z;
    unsigned sum, cnt, mine, sp = 0u;
    for (;;) {
        sum = 0u; cnt = 0u; mine = 0u;
#pragma unroll
        for (unsigned j = 0; j < 16; ++j) { const unsigned c = xb_ld(&bar[XB_XCNT(j)]); sum += c; cnt += (c > 0u) ? 1u : 0u; mine = (j == x) ? c : mine; }
        if (sum == G) break;
        __builtin_amdgcn_s_sleep(1);
        if ((++sp & 255u) == 0u) { if (xb_ld(&bar[XB_TMO])) break; if (sp > XB_SPIN_CAP) { atomicAdd(&bar[XB_TMO], 1u); break; } }
    }
    nloc = mine > 0u ? mine : 1u; nx = cnt > 0u ? cnt : 1u;
}

__device__ __forceinline__ void xcd_barrier(const XcdBarrier& b) {
    asm volatile("s_waitcnt vmcnt(0)" ::: "memory");
    __syncthreads();
    if (threadIdx.x == 0) {
        unsigned* bar = b.bar;
        __builtin_amdgcn_s_waitcnt(0);
        unsigned nloc = b.st[0], nx = b.st[1];
        if (nloc == 0u) { xcd_barrier_complete(bar, b.x, nloc, nx); b.st[0] = nloc; b.st[1] = nx; }
        const unsigned old = xb_add(&bar[XB_XSUB(b.x)], 1u);
        const unsigned gen = old / nloc;
        if (old + 1u == (gen + 1u) * nloc) {
            __builtin_amdgcn_fence(__ATOMIC_RELEASE, "agent");
            asm volatile("s_waitcnt vmcnt(0)" ::: "memory");
            const unsigned og = xb_add(&bar[XB_TOP], 1u);
            const unsigned tg = og / nx;
            if (og + 1u == (tg + 1u) * nx) xb_add(&bar[XB_TOPGEN], 1u);
            else XB_SPIN(xb_ld(&bar[XB_TOPGEN]) == tg, bar);
            __builtin_amdgcn_fence(__ATOMIC_ACQUIRE, "agent");
            xb_add(&bar[XB_XGEN(b.x)], 1u);
            asm volatile("s_waitcnt vmcnt(0)" ::: "memory");
        } else {
            XB_SPIN(xb_ld(&bar[XB_XGEN(b.x)]) == gen, bar);
            __builtin_amdgcn_fence(__ATOMIC_ACQUIRE, "agent");
            asm volatile("s_waitcnt vmcnt(0)" ::: "memory");
        }
    }
    __syncthreads();
}


__global__ void __launch_bounds__(512, 2) fwd_megakernel(const Params Pk) {
    extern __shared__ __attribute__((aligned(16))) unsigned char lds_raw[];
    LAS unsigned char* lds = (LAS unsigned char*)lds_raw;
    cg::grid_group grid = cg::this_grid();
    const int nphase = ((PP)__builtin_amdgcn_kernarg_segment_ptr())->nphase;
    volatile LAS unsigned* xb_st = (volatile LAS unsigned*)(lds + (LDS_BYTES - 16));
    if (threadIdx.x == 0) { xb_st[0] = 0u; xb_st[1] = 0u; }
    __syncthreads();
    XcdBarrier xbar; xbar.bar = ((PP)__builtin_amdgcn_kernarg_segment_ptr())->bar; xbar.x = xb_xcc_id(); xbar.st = xb_st;
#if PROBE_MASK
    unsigned long long probe_acc = 0;
#endif
    for (int pi = 0; pi < nphase; ++pi) {
        PP P = (PP)__builtin_amdgcn_kernarg_segment_ptr(); asm volatile("" : "+s"(P));
        int tid = threadIdx.x; asm volatile("" : "+v"(tid));
        const int wid = __builtin_amdgcn_readfirstlane(tid >> 6);
#if PROBE_MASK
        const unsigned long long probe_t0 = __builtin_amdgcn_s_memrealtime();
#endif
        Phase ph; ph.kind = P->ph[pi].kind; ph.p0 = P->ph[pi].p0; ph.np = P->ph[pi].np; ph.ld = P->ph[pi].ld; ph.arg = P->ph[pi].arg;
        const int kind = ph.kind;
        if ((PHM & 1) && (kind == K_GEMM || kind == K_DUAL)) {
            gemm_phase(lds, P, ph, tid);
        } else if ((PHM & 2) && kind == K_PRO) {
            prologue_misc(P, tid);
            if (blockIdx.x == 0) { for (int i = tid; i < XCD_BAR_WORDS; i += 512) P->bar[i] = 0u; }
            conv_jobs(lds, P, 0, P->njob0, tid);
        } else if ((PHM & 4) && kind == K_LN) {
            const int li = ph.arg;
            const float* g = P->in[li == 0 ? 4 : (li == 1 ? 16 : (li == 2 ? 23 : 27))];
            const float* b = P->in[li == 0 ? 5 : (li == 1 ? 17 : (li == 2 ? 24 : 28))];
            ln_rows(P->out, g, b, li == 3 ? P->out : (float*)nullptr, li == 3 ? (bf16_t*)nullptr : P->hb, T_, tid, li == 3 ? (float*)nullptr : P->stats);
            if (li == 0) ln_rows(P->in[1], P->in[18], P->in[19], (float*)nullptr, P->memb, 1024, tid);
            if (li == 1) conv_jobs(lds, P, P->njob0, P->njob1, tid);
        } else if ((PHM & 8) && kind == K_PREPA) {
            prep_rows(P, tid);
            for (int u = blockIdx.x; u < 2048; u += gridDim.x) {
                const int bh = u & 63, cp = u >> 6, b = bh >> 4, h = bh & 15;
                const size_t row0 = (size_t)b * S_ + cp * 128;
                bf16_t* q = P->qka + row0 * 2048 + h * 64;
                const bf16_t* k = P->qka + (size_t)b * S_ * 2048 + 1024 + h * 64;
                const bf16_t* vt = P->vta + (size_t)(h * 64) * T_ + (size_t)b * S_;
                const int cw = cp * 2 + (wid >> 2);
                const int tlo = (cp * 2 - 8) < 0 ? 0 : (cp * 2 - 8), wlo = (cw - 8) < 0 ? 0 : (cw - 8);
                attn_unit<64, 64, 64, 1, 4, true>(lds, q, 2048, q, 2048, k, 2048, k, 2048, vt, T_, q, 2048, tlo, cp * 2 + 2, wlo, cw + 1, 0.125f * LOG2E_, cp * 128 + wid * 16, P->in[8] + h * 257, tid);
            }
        } else if ((PHM & 16) && kind == K_MLA) {
            for (int i = 0; ; ++i) {
                int bh, qi;
                if (gridDim.x == 256) { const int x = blockIdx.x & 7, j = blockIdx.x >> 3; if (i >= 4) break; const int rr = 2 * i + (j >> 4), jj = j & 15; bh = x + 8 * rr; qi = (i & 1) ? (15 - jj) : jj; }
                else { const int u = blockIdx.x + i * gridDim.x; if (u >= 1024) break; bh = u & 63; qi = u >> 6; }
                const int b = bh >> 4, h = bh & 15;
                const size_t row0 = (size_t)b * S_ + qi * 256;
                bf16_t* q1 = P->hb + row0 * 2048 + h * 128;
                const bf16_t* q2 = P->qr + row0 * 1024 + h * 64;
                const bf16_t* k1 = P->kn + (size_t)b * S_ * 2048 + h * 128;
                const bf16_t* k2 = P->kpe + (size_t)b * S_ * 64;
                const bf16_t* vt = P->vtb + (size_t)(h * 128) * T_ + (size_t)b * S_;
                const int cw = qi * 4 + (wid >> 1);
                attn_unit32<192, 128, 128>(lds, q1, 2048, q2, 1024, k1, 2048, k2, 64, vt, T_, q1, 2048, 0, qi * 4 + 4, 0, cw + 1, 0.07216878364870322f * LOG2E_, tid);
            }
        } else if ((PHM & 32) && kind == K_XATTN) {
            for (int u = blockIdx.x; u < 1024; u += gridDim.x) {
                const int rbk = u & 31, rest = u >> 5, dvh = rest & 1, h = (rest >> 1) & 3, b = rest >> 3;
                const size_t row0 = (size_t)b * S_ + rbk * 128;
                const bf16_t* q = P->xq + row0 * 2048 + h * 512;
                const bf16_t* k = P->kx + (size_t)(b * 256) * 2048 + h * 512;
                const bf16_t* vt = P->vtx + (size_t)(h * 512 + dvh * 256) * 1024 + b * 256;
                bf16_t* o = P->ox + row0 * 2048 + h * 512 + dvh * 256;
                attn_unit<512, 256, 512, 1, 1, false>(lds, q, 2048, q, 2048, k, 2048, k, 2048, vt, 1024, o, 2048, 0, 4, 0, 4, 0.04419417382415922f * LOG2E_, 0, (const float*)nullptr, tid);
            }
        }
#if PROBE_MASK
        if ((PROBE_MASK >> kind) & 1) probe_acc += __builtin_amdgcn_s_memrealtime() - probe_t0;
#endif
        asm volatile("s_waitcnt vmcnt(0) lgkmcnt(0)" ::: "memory");
        if (pi + 1 < nphase) {
            if (pi == 0) {
                grid.sync();
                if (threadIdx.x == 0) (void)xb_add(&xbar.bar[XB_XCNT(xbar.x)], 1u);
            } else xcd_barrier(xbar); }
    }
#if PROBE_MASK
    { const unsigned long long t0 = __builtin_amdgcn_s_memrealtime(); while (__builtin_amdgcn_s_memrealtime() - t0 < probe_acc) __builtin_amdgcn_s_sleep(8); }
#endif
}

extern "C" void kernel_launch(void* const* d_in, const int* in_sizes, int n_in, void* d_out, int out_size, void* d_ws, size_t ws_size, hipStream_t stream) {
    static int grid_blocks = 0;
    if (grid_blocks == 0) {
        int dev = 0, cus = 0, per_cu = 0;
        hipGetDevice(&dev);
        hipDeviceGetAttribute(&cus, hipDeviceAttributeMultiprocessorCount, dev);
        if (hipFuncSetAttribute((const void*)fwd_megakernel, hipFuncAttributeMaxDynamicSharedMemorySize, LDS_BYTES) != hipSuccess) fprintf(stderr, "hipFuncSetAttribute failed\n");
        if (hipOccupancyMaxActiveBlocksPerMultiprocessor(&per_cu, (const void*)fwd_megakernel, 512, LDS_BYTES) != hipSuccess || per_cu < 1) { fprintf(stderr, "occupancy query: %d\n", per_cu); per_cu = 1; }
        (void)hipGetLastError();
        grid_blocks = cus * per_cu;
        if (grid_blocks > 256) grid_blocks = 256;
        if (grid_blocks < 1) grid_blocks = 256;
    }
    Params p; memset(&p, 0, sizeof(p));
    for (int i = 0; i < 29; ++i) p.in[i] = (const float*)d_in[i];
    p.out = (float*)d_out; p.ws = (unsigned char*)d_ws;
    unsigned char* ws = (unsigned char*)d_ws;
    size_t o = 0;
    const size_t OFF_WMIX = o; o += (size_t)8448 * 2048 * 2;
    const size_t OFF_WQB = o; o += (size_t)3072 * 512 * 2;
    const size_t OFF_WKVB = o; o += (size_t)4096 * 512 * 2;
    const size_t OFF_WOA = o; o += (size_t)2048 * 2048 * 2;
    const size_t OFF_WOB = o; o += (size_t)2048 * 2048 * 2;
    const size_t OFF_WOUT = o; o += (size_t)2048 * 2048 * 2;
    const size_t OFF_WXQ = o; o += (size_t)2048 * 2048 * 2;
    const size_t OFF_WXO = o; o += (size_t)2048 * 2048 * 2;
    const size_t OFF_WXKV = o; o += (size_t)4096 * 2048 * 2;
    const size_t OFF_RF = o; o += (size_t)11008 * 2048 * 2 + (size_t)2048 * 5504 * 2;
    const size_t OFF_ACT = o; o += (size_t)T_ * DFF_ * 2;
    const size_t OFF_Z = o; o += (size_t)T_ * D_ * 4;
    const size_t OFF_HB = o; o += (size_t)T_ * D_ * 2;
    const size_t OFF_KX = o; o += (size_t)1024 * 2048 * 2;
    const size_t OFF_VTX = o; o += (size_t)2048 * 1024 * 2;
    const size_t OFF_ROPE = o; o += (size_t)S_ * 32 * 4 * 2;
    const size_t OFF_QR = o; o += (size_t)T_ * 1024 * 2;
    const size_t OFF_BAR = o; o += 16384;
    const size_t OFF_STATS = o; o += (size_t)T_ * 2 * 4;
    const size_t WS_END = o;
    if (ws_size < WS_END) fprintf(stderr, "kernel_launch: workspace too small: need %zu, have %zu\n", WS_END, ws_size);
    bf16_t* wmix = (bf16_t*)(ws + OFF_WMIX); bf16_t* wqb = (bf16_t*)(ws + OFF_WQB); bf16_t* wkvb = (bf16_t*)(ws + OFF_WKVB);
    bf16_t* woa = (bf16_t*)(ws + OFF_WOA); bf16_t* wob = (bf16_t*)(ws + OFF_WOB); bf16_t* wout = (bf16_t*)(ws + OFF_WOUT);
    bf16_t* wxq = (bf16_t*)(ws + OFF_WXQ); bf16_t* wxo = (bf16_t*)(ws + OFF_WXO); bf16_t* wxkv = (bf16_t*)(ws + OFF_WXKV);
    bf16_t* w1t = (bf16_t*)(ws + OFF_RF); bf16_t* w2t = w1t + (size_t)11008 * 2048;
    bf16_t* act = (bf16_t*)(ws + OFF_ACT);
    p.z = (float*)(ws + OFF_Z); p.hb = (bf16_t*)(ws + OFF_HB);
    p.lat = (float*)(ws + OFF_RF); p.vtb = (bf16_t*)(ws + OFF_RF); bf16_t* mixg = (bf16_t*)(ws + OFF_RF);
    p.gates = act;
    p.kraw = (float*)(ws + OFF_ACT + (size_t)134217728);
    p.cq = (bf16_t*)(ws + OFF_ACT + (size_t)138412032);
    p.ckv = (bf16_t*)(ws + OFF_ACT + (size_t)155189248);
    p.kpe = (bf16_t*)(ws + OFF_ACT + (size_t)171966464);
    p.memb = (bf16_t*)(ws + OFF_ACT + (size_t)174063616);
    p.wxqn = wxq; p.xq = act; p.ox = (bf16_t*)(ws + OFF_ACT + (size_t)67108864);
    p.qka = (bf16_t*)(ws + OFF_Z); p.vta = (bf16_t*)(ws + OFF_Z + (size_t)67108864); p.kn = (bf16_t*)(ws + OFF_Z + (size_t)67108864);
    p.qr = (bf16_t*)(ws + OFF_QR); p.kx = (bf16_t*)(ws + OFF_KX); p.vtx = (bf16_t*)(ws + OFF_VTX);
    p.cosT = (float*)(ws + OFF_ROPE); p.sinT = p.cosT + (size_t)S_ * 32; p.wmix = wmix;
    p.bar = (unsigned*)(ws + OFF_BAR); p.stats = (float*)(ws + OFF_STATS);
    bf16_t* qn = p.hb;
    float* hf = p.out;
    auto job = [&](int i, int src, bf16_t* dst, const float* ksc, int K, int N, int ldd, int mode) {
        p.job[i].W = p.in[src]; p.job[i].dst = dst; p.job[i].ksc = ksc; p.job[i].K = K; p.job[i].N = N; p.job[i].ldd = ldd; p.job[i].mode = mode; p.job[i].ntiles = (K / 64) * ((N + 255) / 256); };
    job(0, 2, w1t, nullptr, 2048, 11008, 2048, 1);
    job(1, 3, w2t, nullptr, 5504, 2048, 5504, 0);
    job(2, 6, wmix, nullptr, 2048, 8256, 2048, 2);
    job(3, 10, wqb, p.in[9], 512, 3072, 512, 3);
    job(4, 12, wkvb, p.in[11], 512, 4096, 512, 4);
    job(5, 13, woa, nullptr, 1024, 2048, 2048, 0);
    job(6, 14, wob, nullptr, 2048, 2048, 2048, 0);
    job(7, 15, wout, nullptr, 2048, 2048, 2048, 0);
    job(8, 20, wxq, nullptr, 0, 2048, 2048, 0);
    job(9, 21, wxkv, nullptr, 2048, 4096, 2048, 0);
    job(10, 22, wxo, nullptr, 2048, 2048, 2048, 0);
    job(11, 25, w1t, nullptr, 2048, 11008, 2048, 1);
    job(12, 26, w2t, nullptr, 5504, 2048, 5504, 0);
    p.njob0 = 11; p.njob1 = 13;
    int np = 0, nph = 0;
    auto prob = [&](const bf16_t* A, const bf16_t* B, void* out, const void* aux, const void* aux2, int nM, int nN, int K, int epi, int ldo, float f0, float f1) {
        Prob& q = p.pr[np]; q.A = A; q.B = B; q.out = out; q.aux = aux; q.aux2 = aux2; q.nM = nM; q.nN = nN; q.nt = K / 64; q.epi = epi; q.ldo = ldo; q.f0 = f0; q.f1 = f1; return np++; };
    auto phase = [&](int kind, int p0, int npr, int ld, int arg) { Phase& h = p.ph[nph++]; h.kind = kind; h.p0 = p0; h.np = npr; h.ld = ld; h.arg = arg; };
    phase(K_PRO, 0, 0, 0, 0);
    { int a = prob(p.hb, w1t, act, nullptr, nullptr, 64, 43, 2048, E_SWIGLU, DFF_, 0.f, 0.f); phase(K_GEMM, a, 1, 2048, 0); }
    { int a = prob(act, w2t, p.out, p.in[0], nullptr, 64, 8, DFF_, E_RESZ, -1, ALPHA_, 0.5f); phase(K_GEMM, a, 1, DFF_, 0); }
    phase(K_LN, 0, 0, 0, 0);
    { int a = prob(p.hb, wmix, p.qka, nullptr, nullptr, 64, 8, 2048, E_BF16, 2048, 0.f, 0.f);
      prob(wmix + (size_t)2048 * 2048, p.hb, p.vta, nullptr, nullptr, 4, 64, 2048, E_BF16, T_, 0.f, 0.f);
      prob(p.hb, wmix + (size_t)3072 * 2048, p.lat, nullptr, p.kraw, 64, 5, 2048, E_LAT, 1024, 0.f, 0.f);
      prob(p.hb, wmix + (size_t)4352 * 2048, p.gates, p.in[7], nullptr, 64, 16, 2048, E_GATES, 4096, 0.f, 0.f);
      prob(p.memb, wxkv, p.kx, nullptr, nullptr, 4, 8, 2048, E_BF16, 2048, 0.f, 0.f);
      prob(wxkv + (size_t)2048 * 2048, p.memb, p.vtx, nullptr, nullptr, 8, 4, 2048, E_BF16, 1024, 0.f, 0.f);
      phase(K_GEMM, a, 6, 2048, 0); }
    phase(K_PREPA, 0, 0, 0, 0);
    { int a = prob(p.cq, wqb, qn, nullptr, nullptr, 64, 8, 512, E_BF16, 2048, 0.f, 0.f);
      prob(p.cq, wqb + (size_t)2048 * 512, p.qr, p.cosT, p.sinT, 64, 4, 512, E_ROPEQ, 1024, 0.f, 0.f);
      prob(p.ckv, wkvb, p.kn, nullptr, nullptr, 64, 8, 512, E_BF16, 2048, 0.f, 0.f);
      prob(wkvb + (size_t)2048 * 512, p.ckv, p.vtb, nullptr, nullptr, 8, 64, 512, E_BF16, T_, 0.f, 0.f);
      phase(K_GEMM, a, 4, 512, 0); }
    phase(K_MLA, 0, 0, 0, 0);
    { bf16_t* tga = (bf16_t*)(ws + OFF_Z + (size_t)67108864);
      int a = prob(p.qka, woa, tga, p.gates, nullptr, 64, 8, 1024, E_DUAL0, 2048, 0.f, 0.f);
      prob(qn, wob, mixg, p.gates, tga, 64, 8, 2048, E_DUAL1, 2048, 0.f, 0.f);
      phase(K_DUAL, a, 2, 2048, 0); }
    { int a = prob(mixg, wout, p.out, nullptr, p.stats, 64, 8, 2048, E_RESZ, 0, ALPHA_, 1.0f); phase(K_GEMM, a, 1, 2048, 0); }
    phase(K_LN, 0, 0, 0, 1);
    bf16_t* mt = act;
    { int a = -1;
      for (int h = 0; h < 4; ++h) { int q = prob(p.kx + h * 512, wxq + h * 512, mt + (size_t)h * 1024 * 2048, nullptr, nullptr, 4, 8, 512, E_BF16, 2048, 0.f, 0.f); if (h == 0) a = q; }
      phase(K_GEMM, a, 4, 2048, 0); }
    bf16_t* pbuf = (bf16_t*)(ws + OFF_ACT + (size_t)134217728);
    { int a = -1;
      for (int h = 0; h < 4; ++h) { int q = prob(p.hb, mt + (size_t)h * 1024 * 2048, pbuf + h * 256, nullptr, nullptr, 64, 1, 2048, E_SOFTMAX, 1024, 0.04419417382415922f * LOG2E_, 0.f); p.pr[q].bmode = 1; if (h == 0) a = q; }
      phase(K_GEMM, a, 4, 2048, 0); }
    { int a = -1;
      for (int h = 0; h < 4; ++h) { int q = prob(pbuf + h * 256, p.vtx + (size_t)(h * 512) * 1024, p.ox + h * 512, nullptr, nullptr, 64, 2, 256, E_BF16, 2048, 0.f, 0.f); p.pr[q].bmode = 2; if (h == 0) a = q; }
      phase(K_GEMM, a, 4, 1024, 0); }
    { int a = prob(p.ox, wxo, p.out, nullptr, p.stats, 64, 8, 2048, E_RESZ, 1, ALPHA_, 1.0f); phase(K_GEMM, a, 1, 2048, 0); }
    phase(K_LN, 0, 0, 0, 2);
    { int a = prob(p.hb, w1t, act, nullptr, nullptr, 64, 43, 2048, E_SWIGLU, DFF_, 0.f, 0.f); phase(K_GEMM, a, 1, 2048, 0); }
    { int a = prob(act, w2t, p.out, nullptr, p.stats, 64, 8, DFF_, E_RESZ, 2, ALPHA_, 0.5f); phase(K_GEMM, a, 1, DFF_, 0); }
    phase(K_LN, 0, 0, 0, 3);
    p.nphase = nph;
    void* args[] = {(void*)&p};
    hipError_t e = hipLaunchCooperativeKernel((const void*)fwd_megakernel, dim3(grid_blocks), dim3(512), args, LDS_BYTES, stream);
    if (e != hipSuccess) fprintf(stderr, "cooperative launch failed: %s (grid %d)\n", hipGetErrorString(e), grid_blocks);
}
```

```cpp
#include <hip/hip_runtime.h>
#include <hip/hip_cooperative_groups.h>
#include <cstdio>
#include <cstdint>
#include <cstring>
namespace cg = cooperative_groups;

#define LAS __attribute__((address_space(3)))
typedef unsigned short bf16_t;
typedef short bf16x8 __attribute__((ext_vector_type(8)));
typedef float f32x4 __attribute__((ext_vector_type(4)));
typedef float f32x2 __attribute__((ext_vector_type(2)));
typedef unsigned u32x4 __attribute__((ext_vector_type(4)));
typedef unsigned u32x2 __attribute__((ext_vector_type(2)));

constexpr int T_ = 16384, D_ = 2048, S_ = 4096, DFF_ = 5504;
constexpr float ALPHA_ = 1.1892071150027210667f;
constexpr float LOG2E_ = 1.4426950408889634f;
constexpr int LDS_BYTES = 147456;
#ifndef EPIMASK
#define EPIMASK 511
#endif
#define EPIM(e) ((EPIMASK >> (e)) & 1)
#ifndef PROBE_MASK
#define PROBE_MASK 0
#endif
#ifndef PHM
#define PHM 63
#endif

enum { E_BF16 = 0, E_LAT, E_GATES, E_SWIGLU, E_RESZ, E_ROPEQ, E_DUAL0, E_DUAL1, E_SOFTMAX };
enum { K_PRO = 0, K_GEMM, K_DUAL, K_LN, K_PREPA, K_MLA, K_XATTN };

struct Prob {
    const bf16_t* A; const bf16_t* B; void* out; const void* aux; const void* aux2;
    int nM, nN, nt, epi, ldo; float f0, f1; int bmode;
};
struct Phase { int kind, p0, np, ld, arg; };
struct CJob { const float* W; bf16_t* dst; const float* ksc; int K, N, ldd, mode, ntiles, pad; };
struct Params {
    const float* in[29];
    float* out;
    unsigned char* ws;
    float* z; bf16_t* hb; float* lat; float* kraw; bf16_t* cq; bf16_t* ckv; bf16_t* kpe; bf16_t* memb;
    bf16_t* qka; bf16_t* vta; bf16_t* kn; bf16_t* qr; bf16_t* vtb; bf16_t* gates; bf16_t* xq; bf16_t* ox; bf16_t* kx; bf16_t* vtx;
    float* cosT; float* sinT; bf16_t* wmix; bf16_t* wxqn; unsigned* bar; float* stats;
    int nphase, njob0, njob1, pad;
    Phase ph[20];
    Prob pr[32];
    CJob job[13];
};

static_assert(sizeof(Params) <= 4000, "kernel argument too large");
typedef const Params __attribute__((address_space(4)))* PP;

typedef __bf16 bf2_t __attribute__((ext_vector_type(2)));
__device__ __forceinline__ unsigned cvt_pk_bf16(float lo, float hi) { const f32x2 f = {lo, hi}; const bf2_t r = __builtin_convertvector(f, bf2_t); return __builtin_bit_cast(unsigned, r); }
__device__ __forceinline__ float bf_lo(unsigned w) { return __uint_as_float(w << 16); }
__device__ __forceinline__ float bf_hi(unsigned w) { return __uint_as_float(w & 0xffff0000u); }
__device__ __forceinline__ float wave_sum(float v) {
#pragma unroll
    for (int o = 1; o < 64; o <<= 1) v += __shfl_xor(v, o);
    return v;
}
__device__ __forceinline__ float fast_exp2(float x) { return __builtin_amdgcn_exp2f(x); }
__device__ __forceinline__ float sigmoidf_(float x) { return __builtin_amdgcn_rcpf(1.0f + fast_exp2(-x * LOG2E_)); }

constexpr int BM = 256, BK = 64, HALF = 128, HTB = HALF * BK * 2;
__host__ __device__ __forceinline__ int lds_byte(int r, int c) { const int st = (r >> 4) * 2 + (c >> 5), rr = r & 15, cc = c & 31, ob = rr * 64 + cc * 2; return st * 1024 + (ob ^ (((ob >> 9) & 1) << 5)); }
__host__ __device__ __forceinline__ void stage_rc(int b, int& R, int& C) { const int st = b / 1024, sb = b % 1024, swz = sb ^ (((sb >> 9) & 1) << 5); R = (st >> 1) * 16 + swz / 64; C = (st & 1) * 32 + (swz % 64) / 2; }

struct GU { const char* A; const char* B; int nt, pm, pn, pi; };
__device__ __forceinline__ const char* uni_ptr(const char* p) { const unsigned long long v = (unsigned long long)p; const unsigned lo = __builtin_amdgcn_readfirstlane((unsigned)v), hi = __builtin_amdgcn_readfirstlane((unsigned)(v >> 32)); return (const char*)(((unsigned long long)hi << 32) | lo); }

__device__ __forceinline__ bool g_next(PP P, const Phase& ph, int i, GU& u) {
    const int G = gridDim.x, c = blockIdx.x;
    const bool dual = ph.kind == K_DUAL;
    const int ti = dual ? (i >> 1) : i;
    long L = (long)ti * G + c;
    int pi = ph.p0; bool found = false;
    const int np = dual ? 1 : ph.np;
    for (int k = 0; k < np; ++k) { const int cnt = P->pr[pi].nM * P->pr[pi].nN; if (L < cnt) { found = true; break; } L -= cnt; ++pi; }
    if (!__builtin_amdgcn_readfirstlane((int)found)) return false;
    L = __builtin_amdgcn_readfirstlane((int)L); pi = __builtin_amdgcn_readfirstlane(pi);
    const int nM = P->pr[pi].nM, nN = P->pr[pi].nN, nwg = nM * nN;
    int wgid = (int)L; { const int q = nwg / 8, r = nwg % 8, xcd = wgid % 8, off = wgid / 8; wgid = (xcd < r ? xcd * (q + 1) : r * (q + 1) + (xcd - r) * q) + off; }
    const int nig = 8 * nN, gid = wgid / nig, fm = gid * 8, gsz = (nM - fm) < 8 ? (nM - fm) : 8;
    u.pm = __builtin_amdgcn_readfirstlane(fm + ((wgid % nig) % gsz)); u.pn = __builtin_amdgcn_readfirstlane((wgid % nig) / gsz);
    if (dual) pi += (i & 1);
    pi = __builtin_amdgcn_readfirstlane(pi);
    u.pi = pi;
    const size_t tstep = (size_t)BM * ph.ld * 2;
    u.A = uni_ptr((const char*)P->pr[pi].A + (size_t)u.pm * tstep); { const int bm = P->pr[pi].bmode; const size_t boffs = bm == 1 ? (size_t)(u.pm >> 4) * tstep : (bm == 2 ? (size_t)u.pn * tstep + (size_t)(u.pm >> 4) * 512 : (bm == 3 ? (size_t)u.pn * tstep + (size_t)(u.pm >> 4) * ((size_t)2048 * 1024 * 2) : (size_t)u.pn * tstep)); u.B = uni_ptr((const char*)P->pr[pi].B + boffs); } u.nt = __builtin_amdgcn_readfirstlane(P->pr[pi].nt);
    return true;
}

__device__ __forceinline__ u32x4 pack8(const f32x4 a, const f32x4 b) { u32x4 w; w.x = cvt_pk_bf16(a[0], a[1]); w.y = cvt_pk_bf16(a[2], a[3]); w.z = cvt_pk_bf16(b[0], b[1]); w.w = cvt_pk_bf16(b[2], b[3]); return w; }
__device__ __forceinline__ void unpack8(const u32x4 w, f32x4& a, f32x4& b) { a = (f32x4){bf_lo(w.x), bf_hi(w.x), bf_lo(w.y), bf_hi(w.y)}; b = (f32x4){bf_lo(w.z), bf_hi(w.z), bf_lo(w.w), bf_hi(w.w)}; }
__device__ __forceinline__ void g_epi(PP P, const GU& u, f32x4 (&acc)[2][2][4][2], int wr, int wc, int fr, int fq, LAS unsigned char* lds) {
#define pr (P->pr[u.pi])
#ifdef EPIFORCE
    const int epi = EPIFORCE;
#else
    const int epi = pr.epi;
#endif
    const int rowb = u.pm * BM + wr * 64 + fr;
    const int colb = u.pn * BM + wc * 32 + fq * 8;
    if (epi == E_BF16) {
        bf16_t* O = (bf16_t*)pr.out; const int ldo = pr.ldo; const size_t oext = (size_t)u.pn * (size_t)pr.aux2;
#pragma unroll
        for (int ai = 0; ai < 2; ++ai)
#pragma unroll
            for (int m = 0; m < 4; ++m) { asm volatile("" ::: "memory"); bf16_t* rp = O + (size_t)(rowb + ai * HALF + m * 16) * ldo + colb + oext;
#pragma unroll
                for (int bj = 0; bj < 2; ++bj) *(u32x4*)(rp + bj * HALF) = pack8(acc[ai][bj][m][0], acc[ai][bj][m][1]); }
    } else if (EPIM(E_LAT) && epi == E_LAT) {
        if (u.pn < 4) {
            float* O = (float*)pr.out;
#pragma unroll
            for (int ai = 0; ai < 2; ++ai)
#pragma unroll
                for (int m = 0; m < 4; ++m) { asm volatile("" ::: "memory"); float* rp = O + (size_t)(rowb + ai * HALF + m * 16) * 1024 + colb;
#pragma unroll
                    for (int bj = 0; bj < 2; ++bj)
#pragma unroll
                        for (int n = 0; n < 2; ++n) *(f32x4*)(rp + bj * HALF + n * 4) = acc[ai][bj][m][n]; }
        } else if (wc < 2) {
            float* O = (float*)pr.aux2;
#pragma unroll
            for (int ai = 0; ai < 2; ++ai)
#pragma unroll
                for (int m = 0; m < 4; ++m) { asm volatile("" ::: "memory"); float* rp = O + (size_t)(rowb + ai * HALF + m * 16) * 64 + wc * 32 + fq * 8;
#pragma unroll
                    for (int n = 0; n < 2; ++n) *(f32x4*)(rp + n * 4) = acc[ai][0][m][n]; }
        }
    } else if (EPIM(E_GATES) && epi == E_GATES) {
        bf16_t* O = (bf16_t*)pr.out; const float* bias = (const float*)pr.aux;
#pragma unroll
        for (int bj = 0; bj < 2; ++bj) { const f32x4 b0 = *(const f32x4*)(bias + colb + bj * HALF), b1 = *(const f32x4*)(bias + colb + bj * HALF + 4);
#pragma unroll
            for (int ai = 0; ai < 2; ++ai)
#pragma unroll
                for (int m = 0; m < 4; ++m) { asm volatile("" ::: "memory"); f32x4 v0 = acc[ai][bj][m][0] + b0, v1 = acc[ai][bj][m][1] + b1;
#pragma unroll
                    for (int j = 0; j < 4; ++j) { v0[j] = sigmoidf_(v0[j]); v1[j] = sigmoidf_(v1[j]); }
                    *(u32x4*)(O + (size_t)(rowb + ai * HALF + m * 16) * 4096 + colb + bj * HALF) = pack8(v0, v1); } }
    } else if (EPIM(E_SWIGLU) && epi == E_SWIGLU) {
        bf16_t* O = (bf16_t*)pr.out; const int cb = u.pn * 128 + wc * 32 + fq * 8;
#pragma unroll
        for (int ai = 0; ai < 2; ++ai)
#pragma unroll
            for (int m = 0; m < 4; ++m) { asm volatile("" ::: "memory"); f32x4 v[2];
#pragma unroll
                for (int n = 0; n < 2; ++n) { const f32x4 g = acc[ai][0][m][n], uu = acc[ai][1][m][n];
#pragma unroll
                    for (int j = 0; j < 4; ++j) v[n][j] = g[j] * sigmoidf_(g[j]) * uu[j]; }
                *(u32x4*)(O + (size_t)(rowb + ai * HALF + m * 16) * DFF_ + cb) = pack8(v[0], v[1]); }
    } else if (EPIM(E_RESZ) && epi == E_RESZ) {
        float* O = (float*)pr.out; const float f0 = pr.f0, f1 = pr.f1; const int lp = pr.ldo;
        const int colb = u.pn * BM + wc * 32 + fq * 4;
        if (lp < 0) {
            const float* R = (const float*)pr.aux;
#pragma unroll
            for (int ai = 0; ai < 2; ++ai)
#pragma unroll
                for (int m = 0; m < 4; ++m) { asm volatile("" ::: "memory"); const size_t off = (size_t)(rowb + ai * HALF + m * 16) * D_ + colb;
#pragma unroll
                    for (int bj = 0; bj < 2; ++bj)
#pragma unroll
                        for (int n = 0; n < 2; ++n) { const f32x4 r = *(const f32x4*)(R + off + bj * HALF + n * 16); *(f32x4*)(O + off + bj * HALF + n * 16) = r * f0 + acc[ai][bj][m][n] * f1; } }
        } else {
            const float* st = (const float*)pr.aux2;
            const float* g = P->in[lp == 0 ? 4 : (lp == 1 ? 16 : 23)] + colb;
            const float* b = P->in[lp == 0 ? 5 : (lp == 1 ? 17 : 24)] + colb;
            f32x2 ms[2][4];
#pragma unroll
            for (int ai = 0; ai < 2; ++ai)
#pragma unroll
                for (int m = 0; m < 4; ++m) ms[ai][m] = *(const f32x2*)(st + (size_t)(rowb + ai * HALF + m * 16) * 2);
#pragma unroll
            for (int bj = 0; bj < 2; ++bj)
#pragma unroll
                for (int n = 0; n < 2; ++n) { asm volatile("" ::: "memory"); const f32x4 gv = *(const f32x4*)(g + bj * HALF + n * 16), bv = *(const f32x4*)(b + bj * HALF + n * 16);
#pragma unroll
                    for (int ai = 0; ai < 2; ++ai)
#pragma unroll
                        for (int m = 0; m < 4; ++m) { const size_t off = (size_t)(rowb + ai * HALF + m * 16) * D_ + colb + bj * HALF + n * 16; const f32x4 zo = *(const f32x4*)(O + off);
                            const f32x4 h = (zo - ms[ai][m].x) * ms[ai][m].y * gv + bv; *(f32x4*)(O + off) = h * f0 + acc[ai][bj][m][n] * f1; } }
        }
    } else if (EPIM(E_ROPEQ) && epi == E_ROPEQ) {
        bf16_t* O = (bf16_t*)pr.out; const float* cT = (const float*)pr.aux; const float* sT = (const float*)pr.aux2;
        const int head = u.pn * 4 + wc, ri = fq * 8;
#pragma unroll
        for (int ai = 0; ai < 2; ++ai)
#pragma unroll
            for (int m = 0; m < 4; ++m) { asm volatile("" ::: "memory"); const int row = rowb + ai * HALF + m * 16; const int pos = row & (S_ - 1);
                f32x4 o1[2], o2[2];
#pragma unroll
                for (int n = 0; n < 2; ++n) { const f32x4 cs = *(const f32x4*)(cT + pos * 32 + ri + n * 4), sn = *(const f32x4*)(sT + pos * 32 + ri + n * 4);
                    const f32x4 x1 = acc[ai][0][m][n], x2 = acc[ai][1][m][n]; o1[n] = x1 * cs - x2 * sn; o2[n] = x2 * cs + x1 * sn; }
                bf16_t* rp = O + (size_t)row * 1024 + head * 64 + ri; *(u32x4*)rp = pack8(o1[0], o1[1]); *(u32x4*)(rp + 32) = pack8(o2[0], o2[1]); }
    } else if (EPIM(E_SOFTMAX) && epi == E_SOFTMAX) {
        bf16_t* O = (bf16_t*)pr.out; const int ldo = pr.ldo; const float sc = pr.f0;
        int rb_ = wr * 64 + fr; asm volatile("" : "+v"(rb_));
        LAS float* xr = (LAS float*)(lds + 131072) + rb_;
        LAS float* xw = xr + wc * 256;
#pragma unroll
        for (int ai = 0; ai < 2; ++ai)
#pragma unroll
            for (int m = 0; m < 4; ++m) { asm volatile("" ::: "memory"); float mx = -3e38f;
#pragma unroll
                for (int bj = 0; bj < 2; ++bj)
#pragma unroll
                    for (int n = 0; n < 2; ++n) { const f32x4 v = acc[ai][bj][m][n]; mx = fmaxf(fmaxf(mx, fmaxf(v[0], v[1])), fmaxf(v[2], v[3])); }
                mx = fmaxf(mx, __shfl_xor(mx, 16)); mx = fmaxf(mx, __shfl_xor(mx, 32));
                if (fq == 0) xw[ai * HALF + m * 16] = mx; }
        asm volatile("s_waitcnt lgkmcnt(0)" ::: "memory"); __builtin_amdgcn_s_barrier(); asm volatile("" ::: "memory");
#pragma unroll
        for (int ai = 0; ai < 2; ++ai)
#pragma unroll
            for (int m = 0; m < 4; ++m) { asm volatile("" ::: "memory"); const int ro = ai * HALF + m * 16; const float mx = fmaxf(fmaxf(xr[ro], xr[256 + ro]), fmaxf(xr[512 + ro], xr[768 + ro])) * sc; float ps = 0.f;
#pragma unroll
                for (int bj = 0; bj < 2; ++bj)
#pragma unroll
                    for (int n = 0; n < 2; ++n) { const f32x4 v = acc[ai][bj][m][n];
#pragma unroll
                        for (int j = 0; j < 4; ++j) ps += fast_exp2(__builtin_fmaf(v[j], sc, -mx)); }
                ps += __shfl_xor(ps, 16); ps += __shfl_xor(ps, 32);
                if (fq == 0) xw[1024 + ro] = ps; }
        asm volatile("s_waitcnt lgkmcnt(0)" ::: "memory"); __builtin_amdgcn_s_barrier(); asm volatile("" ::: "memory");
#pragma unroll
        for (int ai = 0; ai < 2; ++ai)
#pragma unroll
            for (int m = 0; m < 4; ++m) { asm volatile("" ::: "memory"); const int ro = ai * HALF + m * 16; const float inv = __builtin_amdgcn_rcpf((xr[1024 + ro] + xr[1280 + ro]) + (xr[1536 + ro] + xr[1792 + ro]));
                const float mx = fmaxf(fmaxf(xr[ro], xr[256 + ro]), fmaxf(xr[512 + ro], xr[768 + ro])) * sc;
                bf16_t* rp = O + (size_t)(rowb + ai * HALF + m * 16) * ldo + colb;
#pragma unroll
                for (int bj = 0; bj < 2; ++bj) { f32x4 v[2];
#pragma unroll
                    for (int n = 0; n < 2; ++n) { const f32x4 a = acc[ai][bj][m][n];
#pragma unroll
                        for (int j = 0; j < 4; ++j) v[n][j] = fast_exp2(__builtin_fmaf(a[j], sc, -mx)) * inv; }
                    *(u32x4*)(rp + bj * HALF) = pack8(v[0], v[1]); } }
    } else if (EPIM(E_DUAL0) && epi == E_DUAL0) {
        const bf16_t* G = (const bf16_t*)pr.aux; bf16_t* O = (bf16_t*)pr.out;
#pragma unroll
        for (int ai = 0; ai < 2; ++ai)
#pragma unroll
            for (int m = 0; m < 4; ++m) { asm volatile("" ::: "memory"); const size_t ro = (size_t)(rowb + ai * HALF + m * 16);
#pragma unroll
                for (int bj = 0; bj < 2; ++bj) { f32x4 g0, g1; unpack8(*(const u32x4*)(G + ro * 4096 + colb + bj * HALF), g0, g1);
                    *(u32x4*)(O + ro * D_ + colb + bj * HALF) = pack8(acc[ai][bj][m][0] * g0, acc[ai][bj][m][1] * g1); } }
    } else if (EPIM(E_DUAL1) && epi == E_DUAL1) {
        const bf16_t* G = (const bf16_t*)pr.aux; bf16_t* O = (bf16_t*)pr.out; const bf16_t* Tm = (const bf16_t*)pr.aux2;
#pragma unroll
        for (int ai = 0; ai < 2; ++ai)
#pragma unroll
            for (int m = 0; m < 4; ++m) { asm volatile("" ::: "memory"); const size_t ro = (size_t)(rowb + ai * HALF + m * 16);
#pragma unroll
                for (int bj = 0; bj < 2; ++bj) { f32x4 g0, g1, t0, t1; unpack8(*(const u32x4*)(G + ro * 4096 + 2048 + colb + bj * HALF), g0, g1); unpack8(*(const u32x4*)(Tm + ro * D_ + colb + bj * HALF), t0, t1);
                    *(u32x4*)(O + ro * D_ + colb + bj * HALF) = pack8(t0 + acc[ai][bj][m][0] * g0, t1 + acc[ai][bj][m][1] * g1); } }
    }
}
#undef pr
__device__ __forceinline__ void gemm_phase(LAS unsigned char* lds, PP P, const Phase& ph, const int tid) {
    const int wid = __builtin_amdgcn_readfirstlane(tid >> 6), lane = tid & 63, wr = wid >> 2, wc = wid & 3, fr = lane & 15, fq = lane >> 4;
    const int ld = ph.ld;
    const bool perm = P->pr[ph.p0].epi != E_RESZ;
    unsigned voff[2], voffB[2];
#pragma unroll
    for (int i = 0; i < 2; ++i) { int R, C; stage_rc(tid * 16 + i * 8192, R, C); const int rho = R & 31, Rb = (R & ~31) + (8 * ((rho & 15) >> 2) + 4 * (rho >> 4) + (rho & 3));
        voff[i] = (unsigned)(R * ld + C) * 2u; voffB[i] = (unsigned)((perm ? Rb : R) * ld + C) * 2u; }
    const size_t kstep = (size_t)(BK * 2);
    const size_t hstep = (size_t)HALF * ld * 2;
    const unsigned ldsw = (unsigned)wid * 1024u;
    const int aoff = lds_byte(wr * 64 + fr, fq * 8), boff = lds_byte(wc * 32 + fr, fq * 8);
#define PG8_SA(b, h) (((b) * 2 + (h)) * HTB)
#define PG8_SB(b, h) ((4 + (b) * 2 + (h)) * HTB)
#define PG8_STAGE(bufoff, gbase) do { _Pragma("unroll") for (int _i = 0; _i < 2; ++_i) \
        __builtin_amdgcn_global_load_lds((const unsigned*)((const char*)(gbase) + (((bufoff) >= 4 * HTB) ? voffB[_i] : voff[_i])), (LAS unsigned*)(lds + (bufoff) + ldsw + _i * 8192), 16, 0, 0); } while (0)
#define PG8_LDA(dst, b, h) do { _Pragma("unroll") for (int m = 0; m < 4; ++m) _Pragma("unroll") for (int k = 0; k < 2; ++k) dst[m][k] = *(const LAS bf16x8*)(lds + PG8_SA(b, h) + aoff + m * 2048 + k * 1024); } while (0)
#define PG8_LDB(dst, b, h) do { _Pragma("unroll") for (int n = 0; n < 2; ++n) _Pragma("unroll") for (int k = 0; k < 2; ++k) dst[n][k] = *(const LAS bf16x8*)(lds + PG8_SB(b, h) + boff + n * 2048 + k * 1024); } while (0)
#define PG8_MMA(ai, bj, At, Bt) do { __builtin_amdgcn_s_setprio(1); _Pragma("unroll") for (int m = 0; m < 4; ++m) _Pragma("unroll") for (int n = 0; n < 2; ++n) _Pragma("unroll") for (int k = 0; k < 2; ++k) \
        acc[ai][bj][m][n] = __builtin_amdgcn_mfma_f32_16x16x32_bf16(Bt[n][k], At[m][k], acc[ai][bj][m][n], 0, 0, 0); __builtin_amdgcn_s_setprio(0); } while (0)
#define PG8_WAIT_V(n) asm volatile("s_waitcnt vmcnt(" #n ")" ::: "memory")
#define PG8_WAIT_L(n) asm volatile("s_waitcnt lgkmcnt(" #n ")" ::: "memory")
#define PG8_BAR __builtin_amdgcn_s_barrier()
#define PG8_SCHED __builtin_amdgcn_sched_barrier(0)
    GU cur, nxt; int ui = 0;
    if (!g_next(P, ph, 0, cur)) return;
    f32x4 acc[2][2][4][2];
#pragma unroll
    for (int a = 0; a < 2; ++a)
#pragma unroll
        for (int b = 0; b < 2; ++b)
#pragma unroll
            for (int m = 0; m < 4; ++m)
#pragma unroll
                for (int n = 0; n < 2; ++n) acc[a][b][m][n] = (f32x4){0.f, 0.f, 0.f, 0.f};
    bf16x8 At[4][2], B0[2][2], B1[2][2];
    const char* cA = cur.A; const char* cB = cur.B;
    PG8_STAGE(PG8_SB(0, 0), cB); PG8_STAGE(PG8_SB(0, 1), cB + hstep); PG8_STAGE(PG8_SA(0, 0), cA); PG8_STAGE(PG8_SA(0, 1), cA + hstep);
    if (wr == 1) PG8_BAR;
    PG8_WAIT_V(2); PG8_BAR;
    PG8_STAGE(PG8_SB(1, 0), cB + kstep); PG8_STAGE(PG8_SA(1, 0), cA + kstep); PG8_STAGE(PG8_SB(1, 1), cB + hstep + kstep);
    PG8_WAIT_V(6); PG8_BAR;
    for (;;) {
        const bool has_next = g_next(P, ph, ui + 1, nxt);
        const char* nA = has_next ? nxt.A : cA; const char* nB = has_next ? nxt.B : cB;
        const int nt = cur.nt;
        for (int t = 0; t < nt; t += 2) {
            const bool last = (t == nt - 2);
            const char* a1 = cA + (size_t)(t + 1) * kstep;
            const char* a2 = last ? nA : cA + (size_t)(t + 2) * kstep; const char* b2 = last ? nB : cB + (size_t)(t + 2) * kstep;
            const char* a3 = a2 + kstep; const char* b3 = b2 + kstep;
            PG8_LDB(B0, 0, 0); PG8_LDB(B1, 0, 1); PG8_SCHED; PG8_LDA(At, 0, 0); PG8_STAGE(PG8_SA(1, 1), a1 + hstep);
            PG8_WAIT_V(8); PG8_WAIT_L(0); PG8_BAR; PG8_MMA(0, 0, At, B0); PG8_MMA(0, 1, At, B1); PG8_BAR; PG8_SCHED;
            PG8_LDA(At, 0, 1); PG8_STAGE(PG8_SB(0, 0), b2); PG8_STAGE(PG8_SB(0, 1), b2 + hstep); PG8_STAGE(PG8_SA(0, 0), a2);
            PG8_WAIT_V(8); PG8_WAIT_L(0); PG8_BAR; PG8_MMA(1, 0, At, B0); PG8_MMA(1, 1, At, B1); PG8_BAR; PG8_SCHED;
            PG8_LDB(B0, 1, 0); PG8_LDB(B1, 1, 1); PG8_SCHED; PG8_LDA(At, 1, 0); PG8_STAGE(PG8_SA(0, 1), a2 + hstep);
            PG8_WAIT_V(8); PG8_WAIT_L(0); PG8_BAR; PG8_MMA(0, 0, At, B0); PG8_MMA(0, 1, At, B1); PG8_BAR; PG8_SCHED;
            PG8_LDA(At, 1, 1); PG8_STAGE(PG8_SB(1, 0), b3); PG8_STAGE(PG8_SB(1, 1), b3 + hstep); PG8_STAGE(PG8_SA(1, 0), a3);
            PG8_WAIT_V(8); PG8_WAIT_L(0); PG8_BAR; PG8_MMA(1, 0, At, B0); PG8_MMA(1, 1, At, B1); PG8_BAR; PG8_SCHED;
        }
        if (wr == 0) PG8_BAR;
        g_epi(P, cur, acc, wr, wc, fr, fq, lds);
        if (!has_next) break;
#pragma unroll
        for (int a = 0; a < 2; ++a)
#pragma unroll
            for (int b = 0; b < 2; ++b)
#pragma unroll
                for (int m = 0; m < 4; ++m)
#pragma unroll
                    for (int n = 0; n < 2; ++n) acc[a][b][m][n] = (f32x4){0.f, 0.f, 0.f, 0.f};
        cur = nxt; cA = nA; cB = nB; ++ui;
        if (wr == 1) PG8_BAR;
    }
    PG8_WAIT_V(0);
    PG8_BAR;
#undef PG8_SA
#undef PG8_SB
#undef PG8_STAGE
#undef PG8_LDA
#undef PG8_LDB
#undef PG8_MMA
}

template <int DQK, int DV, int W1, int QB, bool PF, bool BIAS>
__device__ __forceinline__ void attn_unit_reg(LAS unsigned char* lds, const bf16_t* Q1, int ldq1, const bf16_t* Q2, int ldq2,
                                          const bf16_t* K1, int ldk1, const bf16_t* K2, int ldk2, const bf16_t* Vt, int ldv, bf16_t* O, int ldo,
                                          int tlo, int thi, int wlo, int whi, float scale2, int qpos_w, const float* rbias, const int tid) {
    constexpr int KS = DQK * 2 + 16, KBYTES = 64 * KS, VS = 144, VBYTES = DV * VS, NBUF = PF ? 2 : 1;
    constexpr int KC = DQK / 64, VC = DV / 64, NKS = DQK / 32, NDB = DV / 16, CPR = DQK / 8;
    const int wid = __builtin_amdgcn_readfirstlane(tid >> 6), lane = tid & 63, fr = lane & 15, fq = lane >> 4;
    LAS unsigned char* kbase = lds;
    LAS unsigned char* vbase = lds + NBUF * KBYTES;
    LAS float* rb = (LAS float*)(lds + NBUF * (KBYTES + VBYTES));
    if (BIAS) { if (tid < 257) rb[tid] = rbias[tid] * LOG2E_; }
    bf16x8 qf[QB][NKS];
#pragma unroll
    for (int qb = 0; qb < QB; ++qb) { const int row = wid * 16 * QB + qb * 16 + fr;
#pragma unroll
        for (int ks = 0; ks < NKS; ++ks) { const int col = ks * 32 + fq * 8;
            qf[qb][ks] = (col < W1) ? *(const bf16x8*)(Q1 + (size_t)row * ldq1 + col) : *(const bf16x8*)(Q2 + (size_t)row * ldq2 + (col - W1)); } }
    f32x4 oacc[QB][NDB];
    float mrun[QB], lrun[QB];
#pragma unroll
    for (int qb = 0; qb < QB; ++qb) { mrun[qb] = -1e30f; lrun[qb] = 0.f;
#pragma unroll
        for (int db = 0; db < NDB; ++db) oacc[qb][db] = (f32x4){0.f, 0.f, 0.f, 0.f}; }
    bf16x8 kreg[KC], vreg[VC];
#define ATT_LOADK(kt) do { \
        _Pragma("unroll") for (int i = 0; i < KC; ++i) { const int ci = tid + 512 * i, row = ci / CPR, col = (ci % CPR) * 8; const size_t key = (size_t)(kt) * 64 + row; \
            kreg[i] = (col < W1) ? *(const bf16x8*)(K1 + key * ldk1 + col) : *(const bf16x8*)(K2 + key * ldk2 + (col - W1)); } } while (0)
#define ATT_LOADV(kt) do { \
        _Pragma("unroll") for (int i = 0; i < VC; ++i) { const int ci = tid + 512 * i, row = ci >> 3, cc = ci & 7; vreg[i] = *(const bf16x8*)(Vt + (size_t)row * ldv + (size_t)(kt) * 64 + cc * 8); } } while (0)
#define ATT_STOREK(buf) do { \
        _Pragma("unroll") for (int i = 0; i < KC; ++i) { const int ci = tid + 512 * i, row = ci / CPR, cc = ci % CPR; *(LAS bf16x8*)(kbase + (buf) * KBYTES + row * KS + cc * 16) = kreg[i]; } } while (0)
#define ATT_STOREV(buf) do { \
        _Pragma("unroll") for (int i = 0; i < VC; ++i) { const int ci = tid + 512 * i, row = ci >> 3, cc = ci & 7; *(LAS bf16x8*)(vbase + (buf) * VBYTES + row * VS + cc * 16) = vreg[i]; } } while (0)
#define ATT_LOAD(kt) do { ATT_LOADK(kt); ATT_LOADV(kt); } while (0)
#define ATT_STORE(buf) do { ATT_STOREK(buf); ATT_STOREV(buf); } while (0)
    if (PF) { ATT_LOAD(tlo); ATT_STORE(0); __syncthreads(); }
    for (int kt = tlo; kt < thi; ++kt) {
        const int cur = PF ? ((kt - tlo) & 1) : 0;
        if (PF) { if (kt + 1 < thi) ATT_LOAD(kt + 1); }
        else { __syncthreads(); ATT_LOADK(kt); ATT_STOREK(0); ATT_LOADV(kt); ATT_STOREV(0); __syncthreads(); }
        if (kt >= wlo && kt < whi) {
            const LAS unsigned char* kb_ = kbase + cur * KBYTES;
            const LAS unsigned char* vb_ = vbase + cur * VBYTES;
            f32x4 sacc[QB][4];
#pragma unroll
            for (int qb = 0; qb < QB; ++qb)
#pragma unroll
                for (int kb = 0; kb < 4; ++kb) sacc[qb][kb] = (f32x4){0.f, 0.f, 0.f, 0.f};
#pragma unroll
            for (int ks = 0; ks < NKS; ++ks) {
#pragma unroll
                for (int kb = 0; kb < 4; ++kb) { const bf16x8 kf = *(const LAS bf16x8*)(kb_ + (kb * 16 + fr) * KS + ks * 64 + fq * 16);
#pragma unroll
                    for (int qb = 0; qb < QB; ++qb) sacc[qb][kb] = __builtin_amdgcn_mfma_f32_16x16x32_bf16(kf, qf[qb][ks], sacc[qb][kb], 0, 0, 0); }
                if (QB > 1) __builtin_amdgcn_sched_barrier(0); }
            bf16x8 pf[QB][2];
#pragma unroll
            for (int qb = 0; qb < QB; ++qb) {
                float mx = -3e38f;
#pragma unroll
                for (int kb = 0; kb < 4; ++kb)
#pragma unroll
                    for (int j = 0; j < 4; ++j) { float s = sacc[qb][kb][j] * scale2;
                        if (BIAS) { int dist = (qpos_w + qb * 16 + fr) - (kt * 64 + kb * 16 + fq * 4 + j); dist = dist < -128 ? -128 : (dist > 128 ? 128 : dist); s += rb[dist + 128]; }
                        sacc[qb][kb][j] = s; mx = fmaxf(mx, s); }
                mx = fmaxf(mx, __shfl_xor(mx, 16)); mx = fmaxf(mx, __shfl_xor(mx, 32));
                const float mn = fmaxf(mrun[qb], mx); const float al = fast_exp2(mrun[qb] - mn); mrun[qb] = mn;
                float ps = 0.f;
#pragma unroll
                for (int kb = 0; kb < 4; ++kb)
#pragma unroll
                    for (int j = 0; j < 4; ++j) { const float p = fast_exp2(sacc[qb][kb][j] - mn); sacc[qb][kb][j] = p; ps += p; }
                lrun[qb] = lrun[qb] * al + ps;
#pragma unroll
                for (int db = 0; db < NDB; ++db) oacc[qb][db] = oacc[qb][db] * al;
#pragma unroll
                for (int ks = 0; ks < 2; ++ks) { u32x4 w; w.x = cvt_pk_bf16(sacc[qb][2 * ks][0], sacc[qb][2 * ks][1]); w.y = cvt_pk_bf16(sacc[qb][2 * ks][2], sacc[qb][2 * ks][3]);
                    w.z = cvt_pk_bf16(sacc[qb][2 * ks + 1][0], sacc[qb][2 * ks + 1][1]); w.w = cvt_pk_bf16(sacc[qb][2 * ks + 1][2], sacc[qb][2 * ks + 1][3]);
                    pf[qb][ks] = __builtin_bit_cast(bf16x8, w); }
            }
#pragma unroll
            for (int db = 0; db < NDB; ++db) { if (QB > 1) __builtin_amdgcn_sched_barrier(0);
#pragma unroll
                for (int ks = 0; ks < 2; ++ks) { const LAS unsigned char* vp = vb_ + (db * 16 + fr) * VS + ks * 64 + fq * 8;
                    const u32x2 v0 = *(const LAS u32x2*)vp, v1 = *(const LAS u32x2*)(vp + 32); u32x4 w; w.x = v0.x; w.y = v0.y; w.z = v1.x; w.w = v1.y;
                    const bf16x8 vf = __builtin_bit_cast(bf16x8, w);
#pragma unroll
                    for (int qb = 0; qb < QB; ++qb) oacc[qb][db] = __builtin_amdgcn_mfma_f32_16x16x32_bf16(vf, pf[qb][ks], oacc[qb][db], 0, 0, 0); } }
        }
        if (PF) { if (kt + 1 < thi) ATT_STORE(cur ^ 1); __syncthreads(); }
    }
    if (!PF) __syncthreads();
#pragma unroll
    for (int qb = 0; qb < QB; ++qb) { float l = lrun[qb]; l += __shfl_xor(l, 16); l += __shfl_xor(l, 32); const float inv = 1.0f / l;
        bf16_t* rp = O + (size_t)(wid * 16 * QB + qb * 16 + fr) * ldo + fq * 4;
#pragma unroll
        for (int db = 0; db < NDB; ++db) { const f32x4 v = oacc[qb][db] * inv; u32x2 w; w.x = cvt_pk_bf16(v[0], v[1]); w.y = cvt_pk_bf16(v[2], v[3]); *(u32x2*)(rp + db * 16) = w; } }
#undef ATT_LOAD
#undef ATT_STORE
#undef ATT_LOADK
#undef ATT_LOADV
#undef ATT_STOREK
#undef ATT_STOREV
}

template <int N> __device__ __forceinline__ void wait_vm() {
    if (N == 2) asm volatile("s_waitcnt vmcnt(2)" ::: "memory");
    else if (N == 5) asm volatile("s_waitcnt vmcnt(5)" ::: "memory");
    else if (N == 10) asm volatile("s_waitcnt vmcnt(10)" ::: "memory");
    else asm volatile("s_waitcnt vmcnt(0)" ::: "memory");
}
template <int DQK, int DV, int W1, int QB, int NBUF, bool BIAS>
__device__ __forceinline__ void attn_unit(LAS unsigned char* lds, const bf16_t* Q1, int ldq1, const bf16_t* Q2, int ldq2,
                                          const bf16_t* K1, int ldk1, const bf16_t* K2, int ldk2, const bf16_t* Vt, int ldv, bf16_t* O, int ldo,
                                          int tlo, int thi, int wlo, int whi, float scale2, int qpos_w, const float* rbias, const int tid) {
    constexpr int KSTR = DQK * 2, KBYTES = 64 * KSTR, VBYTES = DV * 128;
    constexpr int KC = DQK / 64, VC = DV / 64, NKS = DQK / 32, NDB = DV / 16, CPR = DQK / 8, NDMA = KC + VC;
    const int wid = __builtin_amdgcn_readfirstlane(tid >> 6), lane = tid & 63, fr = lane & 15, fq = lane >> 4;
    LAS unsigned char* kbase = lds;
    LAS unsigned char* vbase = lds + NBUF * KBYTES;
    LAS float* rb = (LAS float*)(lds + NBUF * (KBYTES + VBYTES));
    if (BIAS) { if (tid < 257) rb[tid] = rbias[tid] * LOG2E_; asm volatile("s_waitcnt lgkmcnt(0)" ::: "memory"); }
    const bf16_t* kp[KC]; int kst[KC]; const bf16_t* vp[VC];
#pragma unroll
    for (int i = 0; i < KC; ++i) { const int q = (i * 8 + wid) * 64 + lane, r = q / CPR, pc = q % CPR; const int c = (pc & ~7) | ((pc & 7) ^ ((r >> 1) & 7)); const int col = c * 8;
        if (col < W1) { kp[i] = K1 + (size_t)r * ldk1 + col; kst[i] = 64 * ldk1; } else { kp[i] = K2 + (size_t)r * ldk2 + (col - W1); kst[i] = 64 * ldk2; } }
#pragma unroll
    for (int i = 0; i < VC; ++i) { const int q = (i * 8 + wid) * 64 + lane, r = q >> 3, pc = q & 7; const int c = pc ^ ((r >> 1) & 7); vp[i] = Vt + (size_t)r * ldv + c * 8; }
#define ATT_ISSUE(kt, buf) do { \
        _Pragma("unroll") for (int i = 0; i < KC; ++i) __builtin_amdgcn_global_load_lds((const unsigned*)(kp[i] + (size_t)(kt) * kst[i]), (LAS unsigned*)(kbase + (buf) * KBYTES + (i * 8 + wid) * 1024), 16, 0, 0); \
        _Pragma("unroll") for (int i = 0; i < VC; ++i) __builtin_amdgcn_global_load_lds((const unsigned*)(vp[i] + (size_t)(kt) * 64), (LAS unsigned*)(vbase + (buf) * VBYTES + (i * 8 + wid) * 1024), 16, 0, 0); } while (0)
    const int xs = (fr >> 1) & 7;
    const int koffA = fr * KSTR + 16 * ((xs >> 2) * 4 + (fq ^ (xs & 3))), koffB = fr * KSTR + 16 * (((xs >> 2) ^ 1) * 4 + (fq ^ (xs & 3)));
    int voff[2][2];
#pragma unroll
    for (int ks = 0; ks < 2; ++ks)
#pragma unroll
        for (int hf = 0; hf < 2; ++hf) voff[ks][hf] = fr * 128 + 16 * ((ks * 4 + hf * 2 + (fq >> 1)) ^ xs) + (fq & 1) * 8;
    bf16x8 qf[QB][NKS];
#pragma unroll
    for (int qb = 0; qb < QB; ++qb) { const int row = wid * 16 * QB + qb * 16 + fr;
#pragma unroll
        for (int ks = 0; ks < NKS; ++ks) { const int col = ks * 32 + fq * 8;
            qf[qb][ks] = (col < W1) ? *(const bf16x8*)(Q1 + (size_t)row * ldq1 + col) : *(const bf16x8*)(Q2 + (size_t)row * ldq2 + (col - W1)); } }
    f32x4 oacc[QB][NDB];
    float mrun[QB], lrun[QB];
#pragma unroll
    for (int qb = 0; qb < QB; ++qb) { mrun[qb] = -1e30f; lrun[qb] = 0.f;
#pragma unroll
        for (int db = 0; db < NDB; ++db) oacc[qb][db] = (f32x4){0.f, 0.f, 0.f, 0.f}; }
    const int nt = thi - tlo;
    asm volatile("s_waitcnt vmcnt(0)" ::: "memory");
#pragma unroll
    for (int qb = 0; qb < QB; ++qb)
#pragma unroll
        for (int ks = 0; ks < NKS; ++ks) asm volatile("" : "+v"(qf[qb][ks]));
    if (NBUF > 1) { ATT_ISSUE(tlo, 0); if (nt > 1) ATT_ISSUE(tlo + 1, 1); }
    int cur = 0;
    constexpr int TPG = (NBUF == 4) ? 2 : 1;
    for (int t = 0; t < nt; ++t) {
        const int kt = tlo + t;
        if (NBUF == 4) {
            if ((t & 1) == 0) {
                wait_vm<0>(); __builtin_amdgcn_s_barrier(); asm volatile("" ::: "memory");
                const int nb = ((t >> 1) & 1) ? 0 : 2;
                if (t + 2 < nt) { ATT_ISSUE(kt + 2, nb); if (t + 3 < nt) ATT_ISSUE(kt + 3, nb + 1); }
            }
            cur = (((t >> 1) & 1) ? 2 : 0) + (t & 1);
        } else if (NBUF > 1) {
            if (t + 1 < nt) wait_vm<NDMA>(); else wait_vm<0>();
            __builtin_amdgcn_s_barrier(); asm volatile("" ::: "memory");
            if (t + 2 < nt) { const int nb = cur + 2 >= NBUF ? cur + 2 - NBUF : cur + 2; ATT_ISSUE(kt + 2, nb); }
        } else {
            asm volatile("" ::: "memory"); __builtin_amdgcn_s_barrier(); asm volatile("" ::: "memory");
            ATT_ISSUE(kt, 0); wait_vm<0>(); __builtin_amdgcn_s_barrier(); asm volatile("" ::: "memory");
        }
        if (kt >= wlo && kt < whi) {
            const LAS unsigned char* kb_ = kbase + cur * KBYTES;
            const LAS unsigned char* vb_ = vbase + cur * VBYTES;
            f32x4 sacc[QB][4];
#pragma unroll
            for (int qb = 0; qb < QB; ++qb)
#pragma unroll
                for (int kb = 0; kb < 4; ++kb) sacc[qb][kb] = (f32x4){0.f, 0.f, 0.f, 0.f};
#pragma unroll
            for (int ks = 0; ks < NKS; ++ks) {
#pragma unroll
                for (int kb = 0; kb < 4; ++kb) { const bf16x8 kf = *(const LAS bf16x8*)(kb_ + ((ks & 1) ? koffB : koffA) + kb * 16 * KSTR + (ks >> 1) * 128);
#pragma unroll
                    for (int qb = 0; qb < QB; ++qb) sacc[qb][kb] = __builtin_amdgcn_mfma_f32_16x16x32_bf16(kf, qf[qb][ks], sacc[qb][kb], 0, 0, 0); }
            }
            bf16x8 pf[QB][2];
#pragma unroll
            for (int qb = 0; qb < QB; ++qb) {
                float mx = -3e38f;
#pragma unroll
                for (int kb = 0; kb < 4; ++kb)
#pragma unroll
                    for (int j = 0; j < 4; ++j) { float s = sacc[qb][kb][j];
                        if (BIAS) { int dist = (qpos_w + qb * 16 + fr) - (kt * 64 + kb * 16 + fq * 4 + j); dist = dist < -128 ? -128 : (dist > 128 ? 128 : dist); s = s * scale2 + rb[dist + 128]; sacc[qb][kb][j] = s; }
                        mx = fmaxf(mx, s); }
                mx = fmaxf(mx, __shfl_xor(mx, 16)); mx = fmaxf(mx, __shfl_xor(mx, 32));
                if (!BIAS) mx *= scale2;
                const float mn = fmaxf(mrun[qb], mx); const float al = fast_exp2(mrun[qb] - mn); mrun[qb] = mn;
                float ps = 0.f;
#pragma unroll
                for (int kb = 0; kb < 4; ++kb)
#pragma unroll
                    for (int j = 0; j < 4; ++j) { const float p = BIAS ? fast_exp2(sacc[qb][kb][j] - mn) : fast_exp2(__builtin_fmaf(sacc[qb][kb][j], scale2, -mn)); sacc[qb][kb][j] = p; ps += p; }
                lrun[qb] = lrun[qb] * al + ps;
                if (__any(al != 1.0f)) {
#pragma unroll
                    for (int db = 0; db < NDB; ++db) oacc[qb][db] = oacc[qb][db] * al; }
#pragma unroll
                for (int ks = 0; ks < 2; ++ks) { u32x4 w; w.x = cvt_pk_bf16(sacc[qb][2 * ks][0], sacc[qb][2 * ks][1]); w.y = cvt_pk_bf16(sacc[qb][2 * ks][2], sacc[qb][2 * ks][3]);
                    w.z = cvt_pk_bf16(sacc[qb][2 * ks + 1][0], sacc[qb][2 * ks + 1][1]); w.w = cvt_pk_bf16(sacc[qb][2 * ks + 1][2], sacc[qb][2 * ks + 1][3]);
                    pf[qb][ks] = __builtin_bit_cast(bf16x8, w); }
            }
#pragma unroll
            for (int db = 0; db < NDB; ++db) {
#pragma unroll
                for (int ks = 0; ks < 2; ++ks) {
                    const u32x2 v0 = *(const LAS u32x2*)(vb_ + voff[ks][0] + db * 2048), v1 = *(const LAS u32x2*)(vb_ + voff[ks][1] + db * 2048); u32x4 w; w.x = v0.x; w.y = v0.y; w.z = v1.x; w.w = v1.y;
                    const bf16x8 vf = __builtin_bit_cast(bf16x8, w);
#pragma unroll
                    for (int qb = 0; qb < QB; ++qb) oacc[qb][db] = __builtin_amdgcn_mfma_f32_16x16x32_bf16(vf, pf[qb][ks], oacc[qb][db], 0, 0, 0); } }
        }
        if (NBUF > 1 && NBUF != 4) { cur = cur + 1 >= NBUF ? 0 : cur + 1; }
    }
    asm volatile("" ::: "memory"); __builtin_amdgcn_s_barrier(); asm volatile("" ::: "memory");
#pragma unroll
    for (int qb = 0; qb < QB; ++qb) { float l = lrun[qb]; l += __shfl_xor(l, 16); l += __shfl_xor(l, 32); const float inv = 1.0f / l;
        bf16_t* rp = O + (size_t)(wid * 16 * QB + qb * 16 + fr) * ldo + fq * 4;
#pragma unroll
        for (int db = 0; db < NDB; ++db) { const f32x4 v = oacc[qb][db] * inv; u32x2 w; w.x = cvt_pk_bf16(v[0], v[1]); w.y = cvt_pk_bf16(v[2], v[3]); *(u32x2*)(rp + db * 16) = w; } }
    asm volatile("s_waitcnt vmcnt(0)" ::: "memory");
#undef ATT_ISSUE
}

typedef float f32x16 __attribute__((ext_vector_type(16)));
template <int DQK, int DV, int W1>
__device__ __forceinline__ void attn_unit32(LAS unsigned char* lds, const bf16_t* Q1, int ldq1, const bf16_t* Q2, int ldq2,
                                            const bf16_t* K1, int ldk1, const bf16_t* K2, int ldk2, const bf16_t* Vt, int ldv, bf16_t* O, int ldo,
                                            int tlo, int thi, int wlo, int whi, float scale2, const int tid) {
    constexpr int NBUF = 3, KSTR = DQK * 2, KBYTES = 64 * KSTR, VBYTES = DV * 128;
    constexpr int KC = DQK / 64, VC = DV / 64, NK16 = DQK / 16, NDB = DV / 32, CPR = DQK / 8, NDMA = KC + VC;
    const int wid = __builtin_amdgcn_readfirstlane(tid >> 6), lane = tid & 63, lr = lane & 31, lh = lane >> 5;
    LAS unsigned char* kbase = lds;
    LAS unsigned char* vbase = lds + NBUF * KBYTES;
    const bf16_t* kp[KC]; int kst[KC]; const bf16_t* vp[VC];
#pragma unroll
    for (int i = 0; i < KC; ++i) { const int q = (i * 8 + wid) * 64 + lane, r = q / CPR, pc = q % CPR; const int c = (pc & ~7) | ((pc & 7) ^ ((r >> 1) & 7)); const int col = c * 8;
        if (col < W1) { kp[i] = K1 + (size_t)r * ldk1 + col; kst[i] = 64 * ldk1; } else { kp[i] = K2 + (size_t)r * ldk2 + (col - W1); kst[i] = 64 * ldk2; } }
#pragma unroll
    for (int i = 0; i < VC; ++i) { const int q = (i * 8 + wid) * 64 + lane, r = q >> 3, pc = q & 7; const int c = pc ^ ((r >> 1) & 7);
        const int rs = (r & ~12) | ((r & 4) << 1) | ((r & 8) >> 1);
        vp[i] = Vt + (size_t)rs * ldv + c * 8; }
#define ATT_ISSUE(kt, buf) do { \
        _Pragma("unroll") for (int i = 0; i < KC; ++i) __builtin_amdgcn_global_load_lds((const unsigned*)(kp[i] + (size_t)(kt) * kst[i]), (LAS unsigned*)(kbase + (buf) * KBYTES + (i * 8 + wid) * 1024), 16, 0, 0); \
        _Pragma("unroll") for (int i = 0; i < VC; ++i) __builtin_amdgcn_global_load_lds((const unsigned*)(vp[i] + (size_t)(kt) * 64), (LAS unsigned*)(vbase + (buf) * VBYTES + (i * 8 + wid) * 1024), 16, 0, 0); } while (0)
    const int xs = (lr >> 1) & 7;
    int koff[4];
#pragma unroll
    for (int j = 0; j < 4; ++j) koff[j] = lr * KSTR + 16 * ((2 * j + lh) ^ xs);
    int voff[8];
#pragma unroll
    for (int c = 0; c < 8; ++c) voff[c] = lr * 128 + 16 * (c ^ xs) + 8 * lh;
    bf16x8 qf[NK16];
#pragma unroll
    for (int s16 = 0; s16 < NK16; ++s16) { const int col = s16 * 16 + lh * 8; const int row = wid * 32 + lr;
        qf[s16] = (col < W1) ? *(const bf16x8*)(Q1 + (size_t)row * ldq1 + col) : *(const bf16x8*)(Q2 + (size_t)row * ldq2 + (col - W1)); }
    f32x16 oacc[NDB];
#pragma unroll
    for (int db = 0; db < NDB; ++db)
#pragma unroll
        for (int r = 0; r < 16; ++r) oacc[db][r] = 0.f;
    float mrun = -1e30f, lrun = 0.f;
    const int nt = thi - tlo;
    asm volatile("s_waitcnt vmcnt(0)" ::: "memory");
#pragma unroll
    for (int s16 = 0; s16 < NK16; ++s16) asm volatile("" : "+v"(qf[s16]));
    ATT_ISSUE(tlo, 0); if (nt > 1) ATT_ISSUE(tlo + 1, 1);
    int cur = 0;
    for (int t = 0; t < nt; ++t) {
        const int kt = tlo + t;
        if (t + 1 < nt) wait_vm<NDMA>(); else wait_vm<0>();
        __builtin_amdgcn_s_barrier(); asm volatile("" ::: "memory");
        if (t + 2 < nt) { const int nb = cur + 2 >= NBUF ? cur + 2 - NBUF : cur + 2; ATT_ISSUE(kt + 2, nb); }
        if (kt >= wlo && kt < whi) {
            const LAS unsigned char* kb_ = kbase + cur * KBYTES;
            const LAS unsigned char* vb_ = vbase + cur * VBYTES;
            f32x16 sacc[2];
#pragma unroll
            for (int kb = 0; kb < 2; ++kb)
#pragma unroll
                for (int r = 0; r < 16; ++r) sacc[kb][r] = 0.f;
#pragma unroll
            for (int s16 = 0; s16 < NK16; ++s16)
#pragma unroll
                for (int kb = 0; kb < 2; ++kb) { const bf16x8 kf = *(const LAS bf16x8*)(kb_ + koff[s16 & 3] + kb * 32 * KSTR + (s16 >> 2) * 128);
                    sacc[kb] = __builtin_amdgcn_mfma_f32_32x32x16_bf16(kf, qf[s16], sacc[kb], 0, 0, 0); }
            float mx = -3e38f;
#pragma unroll
            for (int kb = 0; kb < 2; ++kb)
#pragma unroll
                for (int r = 0; r < 16; ++r) mx = fmaxf(mx, sacc[kb][r]);
            mx = fmaxf(mx, __shfl_xor(mx, 32)) * scale2;
            float mn = mrun, al = 1.0f;
            if (__any(mx - mrun > 6.0f)) { mn = fmaxf(mrun, mx); al = fast_exp2(mrun - mn); mrun = mn; }
            float ps = 0.f;
#pragma unroll
            for (int kb = 0; kb < 2; ++kb)
#pragma unroll
                for (int r = 0; r < 16; ++r) { const float p = fast_exp2(__builtin_fmaf(sacc[kb][r], scale2, -mn)); sacc[kb][r] = p; ps += p; }
            lrun = lrun * al + ps;
            if (__any(al != 1.0f)) {
#pragma unroll
                for (int db = 0; db < NDB; ++db)
#pragma unroll
                    for (int r = 0; r < 16; ++r) oacc[db][r] *= al; }
            bf16x8 pf[2][2];
#pragma unroll
            for (int kb = 0; kb < 2; ++kb)
#pragma unroll
                for (int sp = 0; sp < 2; ++sp) { u32x4 w; w.x = cvt_pk_bf16(sacc[kb][8 * sp + 0], sacc[kb][8 * sp + 1]); w.y = cvt_pk_bf16(sacc[kb][8 * sp + 2], sacc[kb][8 * sp + 3]);
                    w.z = cvt_pk_bf16(sacc[kb][8 * sp + 4], sacc[kb][8 * sp + 5]); w.w = cvt_pk_bf16(sacc[kb][8 * sp + 6], sacc[kb][8 * sp + 7]); pf[kb][sp] = __builtin_bit_cast(bf16x8, w); }
#pragma unroll
            for (int db = 0; db < NDB; ++db)
#pragma unroll
                for (int kb = 0; kb < 2; ++kb)
#pragma unroll
                    for (int sp = 0; sp < 2; ++sp) { const int c0 = 4 * kb + 2 * sp;
                        const u32x2 v0 = *(const LAS u32x2*)(vb_ + voff[c0] + db * 32 * 128), v1 = *(const LAS u32x2*)(vb_ + voff[c0 + 1] + db * 32 * 128);
                        u32x4 w; w.x = v0.x; w.y = v0.y; w.z = v1.x; w.w = v1.y;
                        oacc[db] = __builtin_amdgcn_mfma_f32_32x32x16_bf16(__builtin_bit_cast(bf16x8, w), pf[kb][sp], oacc[db], 0, 0, 0); }
        }
        cur = cur + 1 >= NBUF ? 0 : cur + 1;
    }
    asm volatile("" ::: "memory"); __builtin_amdgcn_s_barrier(); asm volatile("" ::: "memory");
    { float l = lrun; l += __shfl_xor(l, 32); const float inv = 1.0f / l;
      bf16_t* rp = O + (size_t)(wid * 32 + lr) * ldo + 8 * lh;
#pragma unroll
      for (int db = 0; db < NDB; ++db)
#pragma unroll
          for (int a2 = 0; a2 < 2; ++a2) { u32x4 w; w.x = cvt_pk_bf16(oacc[db][8 * a2] * inv, oacc[db][8 * a2 + 1] * inv); w.y = cvt_pk_bf16(oacc[db][8 * a2 + 2] * inv, oacc[db][8 * a2 + 3] * inv);
              w.z = cvt_pk_bf16(oacc[db][8 * a2 + 4] * inv, oacc[db][8 * a2 + 5] * inv); w.w = cvt_pk_bf16(oacc[db][8 * a2 + 6] * inv, oacc[db][8 * a2 + 7] * inv);
              *(u32x4*)(rp + db * 32 + a2 * 16) = w; } }
    asm volatile("s_waitcnt vmcnt(0)" ::: "memory");
#undef ATT_ISSUE
}

__device__ __forceinline__ int map_row(int mode, int c) {
    if (mode == 1) { const int bj = c / DFF_, q = c % DFF_; return (q >> 7) * 256 + bj * 128 + (q & 127); }
    if (mode == 2) return c < 4160 ? c : c + 192;
    if (mode == 3) { const int h = c / 192, r = c % 192; if (r < 128) return h * 128 + r; const int rr = r - 128; return 2048 + (h >> 2) * 256 + (rr >> 5) * 128 + (h & 3) * 32 + (rr & 31); }
    if (mode == 4) { const int h = c >> 8, r = c & 255; return r < 128 ? h * 128 + r : 2048 + h * 128 + (r - 128); }
    return c;
}

__device__ __forceinline__ void conv_jobs(LAS unsigned char* lds, PP P, int j0, int j1, const int tid) {
    LAS float* tile = (LAS float*)lds;
    const int t = tid;
    int total = 0;
    for (int j = j0; j < j1; ++j) total += P->job[j].ntiles;
    for (int it = blockIdx.x; it < total; it += gridDim.x) {
        int j = j0, l = it;
        while (l >= P->job[j].ntiles) { l -= P->job[j].ntiles; ++j; }
#define J (P->job[j])
        const int N = J.N, nct = (N + 255) / 256; const int kt = l / nct, ct = l % nct; const int k0 = kt * 64, c0 = ct * 256;
        const float* W = J.W; const float* ksc = J.ksc;
        { const int n4 = (t & 63) * 4; const bool ok = (c0 + n4) < N;
          f32x4 v[8];
#pragma unroll
          for (int i = 0; i < 8; ++i) { const int k = (t >> 6) + 8 * i; v[i] = ok ? __builtin_nontemporal_load((const f32x4*)(W + (size_t)(k0 + k) * N + c0 + n4)) : (f32x4){0.f, 0.f, 0.f, 0.f}; }
#pragma unroll
          for (int i = 0; i < 8; ++i) { const int k = (t >> 6) + 8 * i; const float sc = ksc ? ksc[k0 + k] : 1.0f; *(LAS f32x4*)(tile + k * 260 + (n4 ^ (4 * i))) = v[i] * sc; } }
        __syncthreads();
        { const int p = t & 7;
#pragma unroll
          for (int e = 0; e < 4; ++e) { const int n = e * 64 + (t >> 3);
            if (c0 + n < N) { const int row = map_row(J.mode, c0 + n); const LAS float* tp = tile + (8 * p) * 260 + (n ^ (4 * p));
                u32x4 w; w.x = cvt_pk_bf16(tp[0], tp[260]); w.y = cvt_pk_bf16(tp[520], tp[780]); w.z = cvt_pk_bf16(tp[1040], tp[1300]); w.w = cvt_pk_bf16(tp[1560], tp[1820]);
                *(u32x4*)(J.dst + (size_t)row * J.ldd + k0 + 8 * p) = w; } } }
        __syncthreads();
    }
}
#undef J
__device__ __forceinline__ void ln_rows(const float* src, const float* g, const float* b, float* outf, bf16_t* outb, int nrows, const int tid, float* stats = nullptr) {
    const int wid = tid >> 6, lane = tid & 63;
    f32x4 gv[8], bv[8];
#pragma unroll
    for (int i = 0; i < 8; ++i) { gv[i] = *(const f32x4*)(g + (lane + 64 * i) * 4); bv[i] = *(const f32x4*)(b + (lane + 64 * i) * 4); }
    for (int row = blockIdx.x * 8 + wid; row < nrows; row += gridDim.x * 8) {
        const f32x4* p = (const f32x4*)(src + (size_t)row * D_);
        f32x4 v[8]; float s = 0.f;
#pragma unroll
        for (int i = 0; i < 8; ++i) { v[i] = p[lane + 64 * i]; s += (v[i][0] + v[i][1]) + (v[i][2] + v[i][3]); }
        const float mean = wave_sum(s) * (1.0f / D_);
        float q = 0.f;
#pragma unroll
        for (int i = 0; i < 8; ++i) { const f32x4 d = v[i] - mean; q += (d[0] * d[0] + d[1] * d[1]) + (d[2] * d[2] + d[3] * d[3]); }
        const float rstd = 1.0f / sqrtf(wave_sum(q) * (1.0f / D_) + 1e-5f);
        if (stats && lane == 0) { stats[(size_t)row * 2] = mean; stats[(size_t)row * 2 + 1] = rstd; }
#pragma unroll
        for (int i = 0; i < 8; ++i) { const f32x4 y = (v[i] - mean) * rstd * gv[i] + bv[i];
            if (outf) *(f32x4*)(outf + (size_t)row * D_ + (lane + 64 * i) * 4) = y;
            if (outb) { u32x2 w; w.x = cvt_pk_bf16(y[0], y[1]); w.y = cvt_pk_bf16(y[2], y[3]); *(u32x2*)(outb + (size_t)row * D_ + (lane + 64 * i) * 4) = w; } }
    }
}

__device__ __forceinline__ void prologue_misc(PP P, const int tid) {
    const size_t gt = (size_t)blockIdx.x * 512 + tid, gn = (size_t)gridDim.x * 512;
    { const float* x = P->in[0]; bf16_t* xb = P->hb;
      for (size_t i = gt; i < (size_t)T_ * D_ / 8; i += gn) { const f32x4 a = __builtin_nontemporal_load((const f32x4*)(x + i * 8)), b = __builtin_nontemporal_load((const f32x4*)(x + i * 8 + 4));
          u32x4 w; w.x = cvt_pk_bf16(a[0], a[1]); w.y = cvt_pk_bf16(a[2], a[3]); w.z = cvt_pk_bf16(b[0], b[1]); w.w = cvt_pk_bf16(b[2], b[3]); *(u32x4*)(xb + i * 8) = w; } }
    { const float* w = P->in[20]; bf16_t* wb = P->wxqn;
      for (size_t i = gt; i < (size_t)D_ * D_ / 8; i += gn) { const f32x4 a = __builtin_nontemporal_load((const f32x4*)(w + i * 8)), b = __builtin_nontemporal_load((const f32x4*)(w + i * 8 + 4));
          u32x4 v; v.x = cvt_pk_bf16(a[0], a[1]); v.y = cvt_pk_bf16(a[2], a[3]); v.z = cvt_pk_bf16(b[0], b[1]); v.w = cvt_pk_bf16(b[2], b[3]); *(u32x4*)(wb + i * 8) = v; } }
    for (size_t i = gt; i < (size_t)S_ * 32; i += gn) { const int pos = (int)(i >> 5), k = (int)(i & 31);
        const float inv = 1.0f / powf(10000.0f, (float)(2 * k) / 64.0f); const float ang = (float)pos * inv;
        const double a = (double)ang; const double kk = rint(a * 0.15915494309189533577); const float r = (float)(a - kk * 6.283185307179586476925);
        P->cosT[i] = cosf(r); P->sinT[i] = sinf(r); }
    { u32x4* zp = (u32x4*)(P->wmix + (size_t)4160 * D_); const u32x4 z0 = {0u, 0u, 0u, 0u};
      for (size_t i = gt; i < (size_t)192 * D_ * 2 / 16; i += gn) zp[i] = z0; }
}

__device__ __forceinline__ void prep_rows(PP P, const int tid) {
    const int wid = tid >> 6, lane = tid & 63;
    for (int row = blockIdx.x * 8 + wid; row < T_; row += gridDim.x * 8) {
        const float* lp = P->lat + (size_t)row * 1024;
#pragma unroll
        for (int part = 0; part < 2; ++part) {
            const f32x4 a0 = *(const f32x4*)(lp + part * 512 + lane * 4), a1 = *(const f32x4*)(lp + part * 512 + 256 + lane * 4);
            float ss = (a0[0] * a0[0] + a0[1] * a0[1]) + (a0[2] * a0[2] + a0[3] * a0[3]) + (a1[0] * a1[0] + a1[1] * a1[1]) + (a1[2] * a1[2] + a1[3] * a1[3]);
            const float r = 1.0f / sqrtf(wave_sum(ss) * (1.0f / 512.0f) + 1e-6f);
            bf16_t* op = (part == 0 ? P->cq : P->ckv) + (size_t)row * 512;
            u32x2 w0, w1; w0.x = cvt_pk_bf16(a0[0] * r, a0[1] * r); w0.y = cvt_pk_bf16(a0[2] * r, a0[3] * r); w1.x = cvt_pk_bf16(a1[0] * r, a1[1] * r); w1.y = cvt_pk_bf16(a1[2] * r, a1[3] * r);
            *(u32x2*)(op + lane * 4) = w0; *(u32x2*)(op + 256 + lane * 4) = w1;
        }
        if (lane < 32) { const float x1 = P->kraw[(size_t)row * 64 + lane], x2 = P->kraw[(size_t)row * 64 + 32 + lane]; const int pos = row & (S_ - 1);
            const float c = P->cosT[pos * 32 + lane], s = P->sinT[pos * 32 + lane];
            P->kpe[(size_t)row * 64 + lane] = (bf16_t)(cvt_pk_bf16(x1 * c - x2 * s, 0.f) & 0xffffu); P->kpe[(size_t)row * 64 + 32 + lane] = (bf16_t)(cvt_pk_bf16(x2 * c + x1 * s, 0.f) & 0xffffu); }
    }
}

#define XB_TMO      128
#define XB_XCNT(j)  (256  + 64 * (j))
#define XB_XSUB(j)  (1280 + 64 * (j))
#define XB_XGEN(j)  (2304 + 64 * (j))
#define XB_TOP      3328
#define XB_TOPGEN   3392
#define XCD_BAR_WORDS 3456
#define XB_SPIN_CAP (1u << 18)

__device__ __forceinline__ unsigned xb_ld(unsigned* p)              { return __hip_atomic_load(p, __ATOMIC_RELAXED, __HIP_MEMORY_SCOPE_AGENT); }
__device__ __forceinline__ unsigned xb_add(unsigned* p, unsigned v) { return __hip_atomic_fetch_add(p, v, __ATOMIC_RELAXED, __HIP_MEMORY_SCOPE_AGENT); }
__device__ __forceinline__ unsigned xb_xcc_id() { return (unsigned)__builtin_amdgcn_s_getreg((3 << 11) | 20) & 0xFu; }
#define XB_SPIN(cond, bar) do { unsigned _sp = 0; while (cond) { __builtin_amdgcn_s_sleep(1); \
    if ((++_sp & 255u) == 0u) { if (xb_ld(&(bar)[XB_TMO])) break; if (_sp > XB_SPIN_CAP) { atomicAdd(&(bar)[XB_TMO], 1u); break; } } } } while (0)

struct XcdBarrier {
    unsigned* bar; unsigned x;
    volatile LAS unsigned* st;
};

__device__ __forceinline__ XcdBarrier xcd_barrier_post(unsigned* bar, volatile LAS unsigned* st) {
    XcdBarrier b; b.bar = bar; b.x = xb_xcc_id(); b.st = st;
    if (threadIdx.x == 0) (void)xb_add(&bar[XB_XCNT(b.x)], 1u);
    return b;
}
__device__ __forceinline__ void xcd_barrier_complete(unsigned* bar, unsigned x, unsigned& nloc, unsigned& nx) {
    const unsigned G = gridDim.x * gridDim.y * gridDim.z;
    unsigned sum, cnt, mine, sp = 0u;
    for (;;) {
        sum = 0u; cnt = 0u; mine = 0u;
#pragma unroll
        for (unsigned j = 0; j < 16; ++j) { const unsigned c = xb_ld(&bar[XB_XCNT(j)]); sum += c; cnt += (c > 0u) ? 1u : 0u; mine = (j == x) ? c : mine; }
        if (sum == G) break;
        __builtin_amdgcn_s_sleep(1);
        if ((++sp & 255u) == 0u) { if (xb_ld(&bar[XB_TMO])) break; if (sp > XB_SPIN_CAP) { atomicAdd(&bar[XB_TMO], 1u); break; } }
    }
    nloc = mine > 0u ? mine : 1u; nx = cnt > 0u ? cnt : 1u;
}

__device__ __forceinline__ void xcd_barrier(const XcdBarrier& b) {
    asm volatile("s_waitcnt vmcnt(0)" ::: "memory");
    __syncthreads();
    if (threadIdx.x == 0) {
        unsigned* bar = b.bar;
        __builtin_amdgcn_s_waitcnt(0);
        unsigned nloc = b.st[0], nx = b.st[1];
        if (nloc == 0u) { xcd_barrier_complete(bar, b.x, nloc, nx); b.st[0] = nloc; b.st[1] = nx; }
        const unsigned old = xb_add(&bar[XB_XSUB(b.x)], 1u);
        const unsigned gen = old / nloc;
        if (old + 1u == (gen + 1u) * nloc) {
            __builtin_amdgcn_fence(__ATOMIC_RELEASE, "agent");
            asm volatile("s_waitcnt vmcnt(0)" ::: "memory");
            const unsigned og = xb_add(&bar[XB_TOP], 1u);
            const unsigned tg = og / nx;
            if (og + 1u == (tg + 1u) * nx) xb_add(&bar[XB_TOPGEN], 1u);
            else XB_SPIN(xb_ld(&bar[XB_TOPGEN]) == tg, bar);
            __builtin_amdgcn_fence(__ATOMIC_ACQUIRE, "agent");
            xb_add(&bar[XB_XGEN(b.x)], 1u);
            asm volatile("s_waitcnt vmcnt(0)" ::: "memory");
        } else {
            XB_SPIN(xb_ld(&bar[XB_XGEN(b.x)]) == gen, bar);
            __builtin_amdgcn_fence(__ATOMIC_ACQUIRE, "agent");
            asm volatile("s_waitcnt vmcnt(0)" ::: "memory");
        }
    }
    __syncthreads();
}


__global__ void __launch_bounds__(512, 2) fwd_megakernel(const Params Pk) {
    extern __shared__ __attribute__((aligned(16))) unsigned char lds_raw[];
    LAS unsigned char* lds = (LAS unsigned char*)lds_raw;
    cg::grid_group grid = cg::this_grid();
    const int nphase = ((PP)__builtin_amdgcn_kernarg_segment_ptr())->nphase;
    volatile LAS unsigned* xb_st = (volatile LAS unsigned*)(lds + (LDS_BYTES - 16));
    if (threadIdx.x == 0) { xb_st[0] = 0u; xb_st[1] = 0u; }
    __syncthreads();
    XcdBarrier xbar; xbar.bar = ((PP)__builtin_amdgcn_kernarg_segment_ptr())->bar; xbar.x = xb_xcc_id(); xbar.st = xb_st;
#if PROBE_MASK
    unsigned long long probe_acc = 0;
#endif
    for (int pi = 0; pi < nphase; ++pi) {
        PP P = (PP)__builtin_amdgcn_kernarg_segment_ptr(); asm volatile("" : "+s"(P));
        int tid = threadIdx.x; asm volatile("" : "+v"(tid));
        const int wid = __builtin_amdgcn_readfirstlane(tid >> 6);
#if PROBE_MASK
        const unsigned long long probe_t0 = __builtin_amdgcn_s_memrealtime();
#endif
        Phase ph; ph.kind = P->ph[pi].kind; ph.p0 = P->ph[pi].p0; ph.np = P->ph[pi].np; ph.ld = P->ph[pi].ld; ph.arg = P->ph[pi].arg;
        const int kind = ph.kind;
        if ((PHM & 1) && (kind == K_GEMM || kind == K_DUAL)) {
            gemm_phase(lds, P, ph, tid);
        } else if ((PHM & 2) && kind == K_PRO) {
            prologue_misc(P, tid);
            if (blockIdx.x == 0) { for (int i = tid; i < XCD_BAR_WORDS; i += 512) P->bar[i] = 0u; }
            conv_jobs(lds, P, 0, P->njob0, tid);
        } else if ((PHM & 4) && kind == K_LN) {
            const int li = ph.arg;
            const float* g = P->in[li == 0 ? 4 : (li == 1 ? 16 : (li == 2 ? 23 : 27))];
            const float* b = P->in[li == 0 ? 5 : (li == 1 ? 17 : (li == 2 ? 24 : 28))];
            ln_rows(P->out, g, b, li == 3 ? P->out : (float*)nullptr, li == 3 ? (bf16_t*)nullptr : P->hb, T_, tid, li == 3 ? (float*)nullptr : P->stats);
            if (li == 0) ln_rows(P->in[1], P->in[18], P->in[19], (float*)nullptr, P->memb, 1024, tid);
            if (li == 1) conv_jobs(lds, P, P->njob0, P->njob1, tid);
        } else if ((PHM & 8) && kind == K_PREPA) {
            prep_rows(P, tid);
            for (int u = blockIdx.x; u < 2048; u += gridDim.x) {
                const int bh = u & 63, cp = u >> 6, b = bh >> 4, h = bh & 15;
                const size_t row0 = (size_t)b * S_ + cp * 128;
                bf16_t* q = P->qka + row0 * 2048 + h * 64;
                const bf16_t* k = P->qka + (size_t)b * S_ * 2048 + 1024 + h * 64;
                const bf16_t* vt = P->vta + (size_t)(h * 64) * T_ + (size_t)b * S_;
                const int cw = cp * 2 + (wid >> 2);
                const int tlo = (cp * 2 - 8) < 0 ? 0 : (cp * 2 - 8), wlo = (cw - 8) < 0 ? 0 : (cw - 8);
                attn_unit<64, 64, 64, 1, 4, true>(lds, q, 2048, q, 2048, k, 2048, k, 2048, vt, T_, q, 2048, tlo, cp * 2 + 2, wlo, cw + 1, 0.125f * LOG2E_, cp * 128 + wid * 16, P->in[8] + h * 257, tid);
            }
        } else if ((PHM & 16) && kind == K_MLA) {
            for (int i = 0; ; ++i) {
                int bh, qi;
                if (gridDim.x == 256) { const int x = blockIdx.x & 7, j = blockIdx.x >> 3; if (i >= 4) break; const int rr = 2 * i + (j >> 4), jj = j & 15; bh = x + 8 * rr; qi = (i & 1) ? (15 - jj) : jj; }
                else { const int u = blockIdx.x + i * gridDim.x; if (u >= 1024) break; bh = u & 63; qi = u >> 6; }
                const int b = bh >> 4, h = bh & 15;
                const size_t row0 = (size_t)b * S_ + qi * 256;
                bf16_t* q1 = P->hb + row0 * 2048 + h * 128;
                const bf16_t* q2 = P->qr + row0 * 1024 + h * 64;
                const bf16_t* k1 = P->kn + (size_t)b * S_ * 2048 + h * 128;
                const bf16_t* k2 = P->kpe + (size_t)b * S_ * 64;
                const bf16_t* vt = P->vtb + (size_t)(h * 128) * T_ + (size_t)b * S_;
                const int cw = qi * 4 + (wid >> 1);
                attn_unit32<192, 128, 128>(lds, q1, 2048, q2, 1024, k1, 2048, k2, 64, vt, T_, q1, 2048, 0, qi * 4 + 4, 0, cw + 1, 0.07216878364870322f * LOG2E_, tid);
            }
        } else if ((PHM & 32) && kind == K_XATTN) {
            for (int u = blockIdx.x; u < 1024; u += gridDim.x) {
                const int rbk = u & 31, rest = u >> 5, dvh = rest & 1, h = (rest >> 1) & 3, b = rest >> 3;
                const size_t row0 = (size_t)b * S_ + rbk * 128;
                const bf16_t* q = P->xq + row0 * 2048 + h * 512;
                const bf16_t* k = P->kx + (size_t)(b * 256) * 2048 + h * 512;
                const bf16_t* vt = P->vtx + (size_t)(h * 512 + dvh * 256) * 1024 + b * 256;
                bf16_t* o = P->ox + row0 * 2048 + h * 512 + dvh * 256;
                attn_unit<512, 256, 512, 1, 1, false>(lds, q, 2048, q, 2048, k, 2048, k, 2048, vt, 1024, o, 2048, 0, 4, 0, 4, 0.04419417382415922f * LOG2E_, 0, (const float*)nullptr, tid);
            }
        }
#if PROBE_MASK
        if ((PROBE_MASK >> kind) & 1) probe_acc += __builtin_amdgcn_s_memrealtime() - probe_t0;
#endif
        asm volatile("s_waitcnt vmcnt(0) lgkmcnt(0)" ::: "memory");
        if (pi + 1 < nphase) {
            if (pi == 0) {
                grid.sync();
                if (threadIdx.x == 0) (void)xb_add(&xbar.bar[XB_XCNT(xbar.x)], 1u);
            } else xcd_barrier(xbar); }
    }
#if PROBE_MASK
    { const unsigned long long t0 = __builtin_amdgcn_s_memrealtime(); while (__builtin_amdgcn_s_memrealtime() - t0 < probe_acc) __builtin_amdgcn_s_sleep(8); }
#endif
}

extern "C" void kernel_launch(void* const* d_in, const int* in_sizes, int n_in, void* d_out, int out_size, void* d_ws, size_t ws_size, hipStream_t stream) {
    static int grid_blocks = 0;
    if (grid_blocks == 0) {
        int dev = 0, cus = 0, per_cu = 0;
        hipGetDevice(&dev);
        hipDeviceGetAttribute(&cus, hipDeviceAttributeMultiprocessorCount, dev);
        if (hipFuncSetAttribute((const void*)fwd_megakernel, hipFuncAttributeMaxDynamicSharedMemorySize, LDS_BYTES) != hipSuccess) fprintf(stderr, "hipFuncSetAttribute failed\n");
        if (hipOccupancyMaxActiveBlocksPerMultiprocessor(&per_cu, (const void*)fwd_megakernel, 512, LDS_BYTES) != hipSuccess || per_cu < 1) { fprintf(stderr, "occupancy query: %d\n", per_cu); per_cu = 1; }
        (void)hipGetLastError();
        grid_blocks = cus * per_cu;
        if (grid_blocks > 256) grid_blocks = 256;
        if (grid_blocks < 1) grid_blocks = 256;
    }
    Params p; memset(&p, 0, sizeof(p));
    for (int i = 0; i < 29; ++i) p.in[i] = (const float*)d_in[i];
    p.out = (float*)d_out; p.ws = (unsigned char*)d_ws;
    unsigned char* ws = (unsigned char*)d_ws;
    size_t o = 0;
    const size_t OFF_WMIX = o; o += (size_t)8448 * 2048 * 2;
    const size_t OFF_WQB = o; o += (size_t)3072 * 512 * 2;
    const size_t OFF_WKVB = o; o += (size_t)4096 * 512 * 2;
    const size_t OFF_WOA = o; o += (size_t)2048 * 2048 * 2;
    const size_t OFF_WOB = o; o += (size_t)2048 * 2048 * 2;
    const size_t OFF_WOUT = o; o += (size_t)2048 * 2048 * 2;
    const size_t OFF_WXQ = o; o += (size_t)2048 * 2048 * 2;
    const size_t OFF_WXO = o; o += (size_t)2048 * 2048 * 2;
    const size_t OFF_WXKV = o; o += (size_t)4096 * 2048 * 2;
    const size_t OFF_RF = o; o += (size_t)11008 * 2048 * 2 + (size_t)2048 * 5504 * 2;
    const size_t OFF_ACT = o; o += (size_t)T_ * DFF_ * 2;
    const size_t OFF_Z = o; o += (size_t)T_ * D_ * 4;
    const size_t OFF_HB = o; o += (size_t)T_ * D_ * 2;
    const size_t OFF_KX = o; o += (size_t)1024 * 2048 * 2;
    const size_t OFF_VTX = o; o += (size_t)2048 * 1024 * 2;
    const size_t OFF_ROPE = o; o += (size_t)S_ * 32 * 4 * 2;
    const size_t OFF_QR = o; o += (size_t)T_ * 1024 * 2;
    const size_t OFF_BAR = o; o += 16384;
    const size_t OFF_STATS = o; o += (size_t)T_ * 2 * 4;
    const size_t WS_END = o;
    if (ws_size < WS_END) fprintf(stderr, "kernel_launch: workspace too small: need %zu, have %zu\n", WS_END, ws_size);
    bf16_t* wmix = (bf16_t*)(ws + OFF_WMIX); bf16_t* wqb = (bf16_t*)(ws + OFF_WQB); bf16_t* wkvb = (bf16_t*)(ws + OFF_WKVB);
    bf16_t* woa = (bf16_t*)(ws + OFF_WOA); bf16_t* wob = (bf16_t*)(ws + OFF_WOB); bf16_t* wout = (bf16_t*)(ws + OFF_WOUT);
    bf16_t* wxq = (bf16_t*)(ws + OFF_WXQ); bf16_t* wxo = (bf16_t*)(ws + OFF_WXO); bf16_t* wxkv = (bf16_t*)(ws + OFF_WXKV);
    bf16_t* w1t = (bf16_t*)(ws + OFF_RF); bf16_t* w2t = w1t + (size_t)11008 * 2048;
    bf16_t* act = (bf16_t*)(ws + OFF_ACT);
    p.z = (float*)(ws + OFF_Z); p.hb = (bf16_t*)(ws + OFF_HB);
    p.lat = (float*)(ws + OFF_RF); p.vtb = (bf16_t*)(ws + OFF_RF); bf16_t* mixg = (bf16_t*)(ws + OFF_RF);
    p.gates = act;
    p.kraw = (float*)(ws + OFF_ACT + (size_t)134217728);
    p.cq = (bf16_t*)(ws + OFF_ACT + (size_t)138412032);
    p.ckv = (bf16_t*)(ws + OFF_ACT + (size_t)155189248);
    p.kpe = (bf16_t*)(ws + OFF_ACT + (size_t)171966464);
    p.memb = (bf16_t*)(ws + OFF_ACT + (size_t)174063616);
    p.wxqn = wxq; p.xq = act; p.ox = (bf16_t*)(ws + OFF_ACT + (size_t)67108864);
    p.qka = (bf16_t*)(ws + OFF_Z); p.vta = (bf16_t*)(ws + OFF_Z + (size_t)67108864); p.kn = (bf16_t*)(ws + OFF_Z + (size_t)67108864);
    p.qr = (bf16_t*)(ws + OFF_QR); p.kx = (bf16_t*)(ws + OFF_KX); p.vtx = (bf16_t*)(ws + OFF_VTX);
    p.cosT = (float*)(ws + OFF_ROPE); p.sinT = p.cosT + (size_t)S_ * 32; p.wmix = wmix;
    p.bar = (unsigned*)(ws + OFF_BAR); p.stats = (float*)(ws + OFF_STATS);
    bf16_t* qn = p.hb;
    float* hf = p.out;
    auto job = [&](int i, int src, bf16_t* dst, const float* ksc, int K, int N, int ldd, int mode) {
        p.job[i].W = p.in[src]; p.job[i].dst = dst; p.job[i].ksc = ksc; p.job[i].K = K; p.job[i].N = N; p.job[i].ldd = ldd; p.job[i].mode = mode; p.job[i].ntiles = (K / 64) * ((N + 255) / 256); };
    job(0, 2, w1t, nullptr, 2048, 11008, 2048, 1);
    job(1, 3, w2t, nullptr, 5504, 2048, 5504, 0);
    job(2, 6, wmix, nullptr, 2048, 8256, 2048, 2);
    job(3, 10, wqb, p.in[9], 512, 3072, 512, 3);
    job(4, 12, wkvb, p.in[11], 512, 4096, 512, 4);
    job(5, 13, woa, nullptr, 1024, 2048, 2048, 0);
    job(6, 14, wob, nullptr, 2048, 2048, 2048, 0);
    job(7, 15, wout, nullptr, 2048, 2048, 2048, 0);
    job(8, 20, wxq, nullptr, 0, 2048, 2048, 0);
    job(9, 21, wxkv, nullptr, 2048, 4096, 2048, 0);
    job(10, 22, wxo, nullptr, 2048, 2048, 2048, 0);
    job(11, 25, w1t, nullptr, 2048, 11008, 2048, 1);
    job(12, 26, w2t, nullptr, 5504, 2048, 5504, 0);
    p.njob0 = 11; p.njob1 = 13;
    int np = 0, nph = 0;
    auto prob = [&](const bf16_t* A, const bf16_t* B, void* out, const void* aux, const void* aux2, int nM, int nN, int K, int epi, int ldo, float f0, float f1) {
        Prob& q = p.pr[np]; q.A = A; q.B = B; q.out = out; q.aux = aux; q.aux2 = aux2; q.nM = nM; q.nN = nN; q.nt = K / 64; q.epi = epi; q.ldo = ldo; q.f0 = f0; q.f1 = f1; return np++; };
    auto phase = [&](int kind, int p0, int npr, int ld, int arg) { Phase& h = p.ph[nph++]; h.kind = kind; h.p0 = p0; h.np = npr; h.ld = ld; h.arg = arg; };
    phase(K_PRO, 0, 0, 0, 0);
    { int a = prob(p.hb, w1t, act, nullptr, nullptr, 64, 43, 2048, E_SWIGLU, DFF_, 0.f, 0.f); phase(K_GEMM, a, 1, 2048, 0); }
    { int a = prob(act, w2t, p.out, p.in[0], nullptr, 64, 8, DFF_, E_RESZ, -1, ALPHA_, 0.5f); phase(K_GEMM, a, 1, DFF_, 0); }
    phase(K_LN, 0, 0, 0, 0);
    { int a = prob(p.hb, wmix, p.qka, nullptr, nullptr, 64, 8, 2048, E_BF16, 2048, 0.f, 0.f);
      prob(wmix + (size_t)2048 * 2048, p.hb, p.vta, nullptr, nullptr, 4, 64, 2048, E_BF16, T_, 0.f, 0.f);
      prob(p.hb, wmix + (size_t)3072 * 2048, p.lat, nullptr, p.kraw, 64, 5, 2048, E_LAT, 1024, 0.f, 0.f);
      prob(p.hb, wmix + (size_t)4352 * 2048, p.gates, p.in[7], nullptr, 64, 16, 2048, E_GATES, 4096, 0.f, 0.f);
      prob(p.memb, wxkv, p.kx, nullptr, nullptr, 4, 8, 2048, E_BF16, 2048, 0.f, 0.f);
      prob(p.memb, wxkv + (size_t)2048 * 2048, p.vtx, nullptr, nullptr, 4, 8, 2048, E_BF16, 2048, 0.f, 0.f);
      phase(K_GEMM, a, 6, 2048, 0); }
    phase(K_PREPA, 0, 0, 0, 0);
    { int a = prob(p.cq, wqb, qn, nullptr, nullptr, 64, 8, 512, E_BF16, 2048, 0.f, 0.f);
      prob(p.cq, wqb + (size_t)2048 * 512, p.qr, p.cosT, p.sinT, 64, 4, 512, E_ROPEQ, 1024, 0.f, 0.f);
      prob(p.ckv, wkvb, p.kn, nullptr, nullptr, 64, 8, 512, E_BF16, 2048, 0.f, 0.f);
      prob(wkvb + (size_t)2048 * 512, p.ckv, p.vtb, nullptr, nullptr, 8, 64, 512, E_BF16, T_, 0.f, 0.f);
      phase(K_GEMM, a, 4, 512, 0); }
    phase(K_MLA, 0, 0, 0, 0);
    { bf16_t* tga = (bf16_t*)(ws + OFF_Z + (size_t)67108864);
      int a = prob(p.qka, woa, tga, p.gates, nullptr, 64, 8, 1024, E_DUAL0, 2048, 0.f, 0.f);
      prob(qn, wob, mixg, p.gates, tga, 64, 8, 2048, E_DUAL1, 2048, 0.f, 0.f);
      phase(K_DUAL, a, 2, 2048, 0); }
    { int a = prob(mixg, wout, p.out, nullptr, p.stats, 64, 8, 2048, E_RESZ, 0, ALPHA_, 1.0f); phase(K_GEMM, a, 1, 2048, 0); }
    phase(K_LN, 0, 0, 0, 1);
    bf16_t* mt = act;
    { int a = -1;
      for (int h = 0; h < 4; ++h) { int q = prob(p.kx + h * 512, wxq + h * 512, mt + (size_t)h * 1024 * 2048, nullptr, nullptr, 4, 8, 512, E_BF16, 2048, 0.f, 0.f); if (h == 0) a = q; }
      bf16_t* vw_ = act + (size_t)8 * 1024 * 1024;
      for (int h = 0; h < 4; ++h) prob(wxo + h * 512, p.vtx + h * 512, vw_ + h * 256, nullptr, (const void*)(size_t)((size_t)2048 * 1024 - 256), 8, 4, 512, E_BF16, 1024, 0.f, 0.f);
      phase(K_GEMM, a, 8, 2048, 0); }
    bf16_t* pbuf = (bf16_t*)(ws + OFF_ACT + (size_t)134217728);
    { int a = -1;
      for (int h = 0; h < 4; ++h) { int q = prob(p.hb, mt + (size_t)h * 1024 * 2048, pbuf + h * 256, nullptr, nullptr, 64, 1, 2048, E_SOFTMAX, 1024, 0.04419417382415922f * LOG2E_, 0.f); p.pr[q].bmode = 1; if (h == 0) a = q; }
      phase(K_GEMM, a, 4, 2048, 0); }
    { bf16_t* vw_ = act + (size_t)8 * 1024 * 1024;
      int a = prob(pbuf, vw_, p.out, nullptr, p.stats, 64, 8, 1024, E_RESZ, 1, ALPHA_, 1.0f); p.pr[a].bmode = 3; phase(K_GEMM, a, 1, 1024, 0); }
    phase(K_LN, 0, 0, 0, 2);
    { int a = prob(p.hb, w1t, act, nullptr, nullptr, 64, 43, 2048, E_SWIGLU, DFF_, 0.f, 0.f); phase(K_GEMM, a, 1, 2048, 0); }
    { int a = prob(act, w2t, p.out, nullptr, p.stats, 64, 8, DFF_, E_RESZ, 2, ALPHA_, 0.5f); phase(K_GEMM, a, 1, DFF_, 0); }
    phase(K_LN, 0, 0, 0, 3);
    p.nphase = nph;
    void* args[] = {(void*)&p};
    hipError_t e = hipLaunchCooperativeKernel((const void*)fwd_megakernel, dim3(grid_blocks), dim3(512), args, LDS_BYTES, stream);
    if (e != hipSuccess) fprintf(stderr, "cooperative launch failed: %s (grid %d)\n", hipGetErrorString(e), grid_blocks);
}
```
